# Optimizing an MI355X kernel written in HIP

```python
import jax, jax.numpy as jnp
from jax import lax
import numpy as np

D_MODEL = 1024
BATCH = 8
SEQ = 4096
DEPTH = 2
DEC_BATCH = 16
DEC_SEQ = 32
PAST_LEN = 2048

CHUNK = 64
N_MIXERS = 2
N_A = (DEPTH + 1) // 2
N_B = DEPTH // 2
HG_EXPAND = 128
HG_HEADS = D_MODEL // HG_EXPAND
HG_DK = HG_EXPAND
HG_DV = D_MODEL // HG_HEADS
RECUR_BLOCK = 16
CONV_W = 3
D_FF = 4 * D_MODEL
EPS = 1e-6

kernel_name = "hgrn2_shortconv_hybrid_stream_step"


def rmsnorm(x, g):
    xf = x.astype(jnp.float32)
    y = xf * lax.rsqrt(jnp.mean(xf * xf, axis=-1, keepdims=True) + EPS)
    return (y * g.astype(jnp.float32)).astype(x.dtype)


def hgrn2_recurrence(q, log_f, k, v, s0):
    B, T = q.shape[0], q.shape[1]
    L = RECUR_BLOCK
    n = -(-T // L)
    pad = n * L - T
    padw = ((0, 0), (0, pad), (0, 0), (0, 0))
    q, log_f, k, v = [jnp.pad(a.astype(jnp.float32), padw) for a in (q, log_f, k, v)]

    def blocks(a):
        return a.reshape(B, n, L, HG_HEADS, a.shape[-1]).transpose(1, 0, 3, 2, 4)

    qb, gb, kb, vb = blocks(q), blocks(log_f), blocks(k), blocks(v)
    mask = jnp.tril(jnp.ones((L, L), dtype=bool))

    def step(S, inp):
        qj, gj, kj, vj = inp
        b = jnp.cumsum(gj, axis=-2)
        bL = b[..., -1:, :]
        qt = qj * jnp.exp(b)
        kt = kj * jnp.exp(-b)
        A = jnp.where(mask, jnp.einsum('bhtk,bhsk->bhts', qt, kt), 0.0)
        o = jnp.einsum('bhtk,bhkv->bhtv', qt, S) + jnp.einsum('bhts,bhsv->bhtv', A, vj)
        S = jnp.exp(bL[..., 0, :])[..., None] * S + jnp.einsum('bhsk,bhsv->bhkv', kj * jnp.exp(bL - b), vj)
        return S, o

    S, o = lax.scan(step, s0.astype(jnp.float32), (qb, gb, kb, vb))
    o = o.transpose(1, 0, 3, 2, 4).reshape(B, n * L, HG_HEADS, HG_DV)[:, :T]
    return o, S


def hgrn2_mixer(h, s0, w_in, lb, g_norm, w_out):
    B, T, _ = h.shape
    proj = h @ w_in
    q, fl, vi, g = jnp.split(proj, 4, axis=-1)
    lbf = lb.astype(jnp.float32)
    f = lbf + (1.0 - lbf) * jax.nn.sigmoid(fl.astype(jnp.float32))
    log_f = jnp.log(f)
    kk = 1.0 - f
    heads = lambda a, d: a.reshape(B, T, HG_HEADS, d)
    o, S = hgrn2_recurrence(heads(q, HG_DK), heads(log_f, HG_DK), heads(kk, HG_DK), heads(vi, HG_DV), s0)
    o = o * lax.rsqrt(jnp.mean(o * o, axis=-1, keepdims=True) + EPS)
    o = o.reshape(B, T, D_MODEL) * g_norm.astype(jnp.float32) * jax.nn.silu(g.astype(jnp.float32))
    return o.astype(h.dtype) @ w_out, S.astype(h.dtype)


def short_conv_mixer(h, buf, w_in, conv_w, w_out):
    T = h.shape[1]
    proj = h @ w_in
    bg, cg, u = jnp.split(proj, 3, axis=-1)
    z = cg * u
    zc = jnp.concatenate([buf.astype(z.dtype), z], axis=1)
    conv = zc[:, 0:T] * conv_w[0]
    for j in range(1, CONV_W):
        conv = conv + zc[:, j:j + T] * conv_w[j]
    y = bg * conv
    return y @ w_out, zc[:, -(CONV_W - 1):]


def trunk(x, hg_state, cv_state, norm_mix, norm_mlp, norm_final, w_in_hgrn, lb_hgrn,
          g_norm_hgrn, w_out_hgrn, w_in_conv, conv_w, w_out_conv, w_up, w_down):
    lbs = jnp.cumsum(jax.nn.softmax(lb_hgrn.astype(jnp.float32), axis=0), axis=0)
    new_hg, new_cv = [], []
    h = x
    for i in range(DEPTH):
        a = rmsnorm(h, norm_mix[i])
        k = i // N_MIXERS
        if i % N_MIXERS == 0:
            y, s = hgrn2_mixer(a, hg_state[k], w_in_hgrn[k], lbs[k], g_norm_hgrn[k], w_out_hgrn[k])
            new_hg.append(s)
        else:
            y, s = short_conv_mixer(a, cv_state[k], w_in_conv[k], conv_w[k], w_out_conv[k])
            new_cv.append(s)
        h = h + y
        m = rmsnorm(h, norm_mlp[i])
        h = h + jnp.square(jax.nn.relu(m @ w_up[i])) @ w_down[i]
    return rmsnorm(h, norm_final), jnp.stack(new_hg), jnp.stack(new_cv)


def setup_inputs(seed: int = 0) -> dict:
    key = jax.random.key(seed)
    ks = jax.random.split(key, 16)
    f32 = jnp.float32
    nrm = lambda k, shape, s: jax.random.normal(k, shape, f32) * s
    return {
        "x_prompt": nrm(ks[0], (BATCH, SEQ, D_MODEL), 1.0),
        "x_sample": nrm(ks[1], (DEC_BATCH, DEC_SEQ, D_MODEL), 1.0),
        "state_hgrn": nrm(ks[2], (N_A, DEC_BATCH, HG_HEADS, HG_DK, HG_DV), 0.5),
        "state_conv": nrm(ks[3], (N_B, DEC_BATCH, CONV_W - 1, D_MODEL), 1.0),
        "norm_mix": 1.0 + nrm(ks[4], (DEPTH, D_MODEL), 0.02),
        "norm_mlp": 1.0 + nrm(ks[5], (DEPTH, D_MODEL), 0.02),
        "norm_final": 1.0 + nrm(ks[6], (D_MODEL,), 0.02),
        "w_in_hgrn": nrm(ks[7], (N_A, D_MODEL, 4 * D_MODEL), D_MODEL ** -0.5),
        "lb_hgrn": nrm(ks[8], (N_A + 1, HG_HEADS * HG_DK), 0.1),
        "g_norm_hgrn": 1.0 + nrm(ks[9], (N_A, D_MODEL), 0.02),
        "w_out_hgrn": nrm(ks[10], (N_A, D_MODEL, D_MODEL), D_MODEL ** -0.5),
        "w_in_conv": nrm(ks[11], (N_B, D_MODEL, 3 * D_MODEL), D_MODEL ** -0.5),
        "conv_w": nrm(ks[12], (N_B, CONV_W, D_MODEL), CONV_W ** -0.5),
        "w_out_conv": nrm(ks[13], (N_B, D_MODEL, D_MODEL), D_MODEL ** -0.5),
        "w_up": nrm(ks[14], (DEPTH, D_MODEL, D_FF), D_MODEL ** -0.5),
        "w_down": nrm(ks[15], (DEPTH, D_FF, D_MODEL), D_FF ** -0.5),
    }


def reference(x_prompt, x_sample, state_hgrn, state_conv, norm_mix, norm_mlp, norm_final,
              w_in_hgrn, lb_hgrn, g_norm_hgrn, w_out_hgrn, w_in_conv, conv_w, w_out_conv,
              w_up, w_down):
    bp = x_prompt.shape[0]
    hg0 = jnp.zeros((N_A, bp, HG_HEADS, HG_DK, HG_DV), x_prompt.dtype)
    cv0 = jnp.zeros((N_B, bp, CONV_W - 1, D_MODEL), x_prompt.dtype)
    y_prompt, state_hgrn_prompt, state_conv_prompt = trunk(
        x_prompt, hg0, cv0, norm_mix, norm_mlp, norm_final, w_in_hgrn, lb_hgrn,
        g_norm_hgrn, w_out_hgrn, w_in_conv, conv_w, w_out_conv, w_up, w_down)
    y_sample, state_hgrn_sample, state_conv_sample = trunk(
        x_sample, state_hgrn, state_conv, norm_mix, norm_mlp, norm_final, w_in_hgrn, lb_hgrn,
        g_norm_hgrn, w_out_hgrn, w_in_conv, conv_w, w_out_conv, w_up, w_down)
    return (y_prompt, y_sample, state_hgrn_prompt, state_conv_prompt, state_hgrn_sample, state_conv_sample)
```

```cpp
#include <hip/hip_runtime.h>
#include <cstdio>
#include <cstdint>

namespace nv {
constexpr int D = 1024, FF = 4096, H = 8, DK = 128, DV = 128;
constexpr float EPS = 1e-6f;

__global__ __launch_bounds__(256) void k_rmsnorm(const float* __restrict__ x, const float* __restrict__ g, float* __restrict__ y) {
  __shared__ float red[4];
  const size_t row = blockIdx.x; const int t = threadIdx.x;
  const float4 v = ((const float4*)(x + row * D))[t];
  float s = v.x * v.x + v.y * v.y + v.z * v.z + v.w * v.w;
  for (int o = 32; o >= 1; o >>= 1) s += __shfl_xor(s, o);
  if ((t & 63) == 0) red[t >> 6] = s;
  __syncthreads();
  const float tot = red[0] + red[1] + red[2] + red[3];
  const float r = 1.0f / sqrtf(tot * (1.0f / D) + EPS);
  const float4 gg = ((const float4*)g)[t];
  float4 o; o.x = v.x * r * gg.x; o.y = v.y * r * gg.y; o.z = v.z * r * gg.z; o.w = v.w * r * gg.w;
  ((float4*)(y + row * D))[t] = o;
}

template <int MODE>
__global__ __launch_bounds__(256) void k_gemm(const float* __restrict__ A, const float* __restrict__ W, float* __restrict__ C, int M, int N, int K) {
  __shared__ float As[16][64 + 4];
  __shared__ float Ws[16][64 + 4];
  const int t = threadIdx.x, tx = t & 15, ty = t >> 4;
  const int m0 = blockIdx.y * 64, n0 = blockIdx.x * 64;
  float acc[4][4];
#pragma unroll
  for (int i = 0; i < 4; ++i)
#pragma unroll
    for (int j = 0; j < 4; ++j) acc[i][j] = 0.f;
  for (int k0 = 0; k0 < K; k0 += 16) {
    {
      const int r = t >> 2, kk = (t & 3) * 4;
      const float4 v = *(const float4*)(A + (size_t)(m0 + r) * K + k0 + kk);
      As[kk + 0][r] = v.x; As[kk + 1][r] = v.y; As[kk + 2][r] = v.z; As[kk + 3][r] = v.w;
    }
    {
      const int kk = t >> 4, nn = (t & 15) * 4;
      const float4 v = *(const float4*)(W + (size_t)(k0 + kk) * N + n0 + nn);
      *(float4*)&Ws[kk][nn] = v;
    }
    __syncthreads();
#pragma unroll
    for (int kk = 0; kk < 16; ++kk) {
      const float4 a = *(const float4*)&As[kk][ty * 4];
      const float4 b = *(const float4*)&Ws[kk][tx * 4];
      const float av[4] = {a.x, a.y, a.z, a.w}, bv[4] = {b.x, b.y, b.z, b.w};
#pragma unroll
      for (int i = 0; i < 4; ++i)
#pragma unroll
        for (int j = 0; j < 4; ++j) acc[i][j] = fmaf(av[i], bv[j], acc[i][j]);
    }
    __syncthreads();
  }
#pragma unroll
  for (int i = 0; i < 4; ++i) {
    float* cp = C + (size_t)(m0 + ty * 4 + i) * N + n0 + tx * 4;
    float4 o;
    if (MODE == 1) { const float4 old = *(const float4*)cp; o.x = old.x + acc[i][0]; o.y = old.y + acc[i][1]; o.z = old.z + acc[i][2]; o.w = old.w + acc[i][3]; }
    else if (MODE == 2) { float r0 = fmaxf(acc[i][0], 0.f), r1 = fmaxf(acc[i][1], 0.f), r2 = fmaxf(acc[i][2], 0.f), r3 = fmaxf(acc[i][3], 0.f); o.x = r0 * r0; o.y = r1 * r1; o.z = r2 * r2; o.w = r3 * r3; }
    else { o.x = acc[i][0]; o.y = acc[i][1]; o.z = acc[i][2]; o.w = acc[i][3]; }
    *(float4*)cp = o;
  }
}

__global__ __launch_bounds__(128) void k_hgrn_recur(const float* __restrict__ proj, const float* __restrict__ lb_hgrn, const float* __restrict__ s0,
                                                    float* __restrict__ o_out, float* __restrict__ S_out, int T) {
  __shared__ float sf[128], sk[128], sq[128];
  const int seq = blockIdx.x >> 3, hd = blockIdx.x & 7, v = threadIdx.x;
  float S[128];
#pragma unroll
  for (int k = 0; k < 128; ++k) S[k] = s0 ? s0[(((size_t)seq * H + hd) * DK + k) * DV + v] : 0.f;
  const float l0 = lb_hgrn[hd * DK + v], l1 = lb_hgrn[D + hd * DK + v];
  const float mx = fmaxf(l0, l1); const float e0 = expf(l0 - mx), e1 = expf(l1 - mx);
  const float lb = e0 / (e0 + e1);
  for (int t = 0; t < T; ++t) {
    const float* pr = proj + (size_t)(seq * T + t) * 4096;
    const float q = pr[hd * DK + v], fl = pr[1024 + hd * DK + v], vi = pr[2048 + hd * DV + v];
    const float f = lb + (1.0f - lb) * (1.0f / (1.0f + expf(-fl)));
    __syncthreads();
    sf[v] = f; sk[v] = 1.0f - f; sq[v] = q;
    __syncthreads();
    float o = 0.f;
#pragma unroll
    for (int k = 0; k < 128; ++k) { S[k] = fmaf(sf[k], S[k], sk[k] * vi); o = fmaf(S[k], sq[k], o); }
    o_out[(size_t)(seq * T + t) * D + hd * DV + v] = o;
  }
#pragma unroll
  for (int k = 0; k < 128; ++k) S_out[(((size_t)seq * H + hd) * DK + k) * DV + v] = S[k];
}

__global__ __launch_bounds__(256) void k_hgrn_out(const float* __restrict__ o, const float* __restrict__ proj, const float* __restrict__ g_norm, float* __restrict__ y) {
  const size_t row = blockIdx.x; const int t = threadIdx.x;
  const float4 v = ((const float4*)(o + row * D))[t];
  float s = v.x * v.x + v.y * v.y + v.z * v.z + v.w * v.w;
  for (int off = 16; off >= 1; off >>= 1) s += __shfl_xor(s, off);
  const float r = 1.0f / sqrtf(s * (1.0f / DV) + EPS);
  const float4 gn = ((const float4*)g_norm)[t];
  const float4 gg = ((const float4*)(proj + row * 4096 + 3072))[t];
  float4 out;
  out.x = v.x * r * gn.x * (gg.x / (1.0f + expf(-gg.x)));
  out.y = v.y * r * gn.y * (gg.y / (1.0f + expf(-gg.y)));
  out.z = v.z * r * gn.z * (gg.z / (1.0f + expf(-gg.z)));
  out.w = v.w * r * gn.w * (gg.w / (1.0f + expf(-gg.w)));
  ((float4*)(y + row * D))[t] = out;
}

__global__ __launch_bounds__(256) void k_conv(const float* __restrict__ proj, const float* __restrict__ conv_w, const float* __restrict__ buf,
                                              float* __restrict__ y, float* __restrict__ buf_out, int T) {
  const int row = blockIdx.x, seq = row / T, t = row % T;
  for (int c = threadIdx.x; c < D; c += 256) {
    const float* pr = proj + (size_t)row * 3072;
    const float z0 = pr[1024 + c] * pr[2048 + c];
    float z1, z2;
    if (t >= 1) { const float* p1 = pr - 3072; z1 = p1[1024 + c] * p1[2048 + c]; } else z1 = buf ? buf[((size_t)seq * 2 + 1) * D + c] : 0.f;
    if (t >= 2) { const float* p2 = pr - 2 * 3072; z2 = p2[1024 + c] * p2[2048 + c]; } else z2 = buf ? buf[((size_t)seq * 2 + (t == 1 ? 1 : 0)) * D + c] : 0.f;
    const float conv = z2 * conv_w[c] + z1 * conv_w[D + c] + z0 * conv_w[2 * D + c];
    y[(size_t)row * D + c] = pr[c] * conv;
    if (t >= T - 2) buf_out[((size_t)seq * 2 + (t - (T - 2))) * D + c] = z0;
  }
}

__global__ void k_copy(const float* __restrict__ s, float* __restrict__ d, size_t n) { size_t i = (size_t)blockIdx.x * blockDim.x + threadIdx.x; for (; i < n; i += (size_t)gridDim.x * blockDim.x) d[i] = s[i]; }

struct In { const float *x_prompt, *x_sample, *state_hgrn, *state_conv, *norm_mix, *norm_mlp, *norm_final, *w_in_hgrn, *lb_hgrn, *g_norm_hgrn, *w_out_hgrn, *w_in_conv, *conv_w, *w_out_conv, *w_up, *w_down; };

static void slab(const In& in, const float* x, float* hbuf, int nseq, int T, const float* s0, const float* cbuf, float* S_out, float* C_out,
                 float* A, float* P, float* O, hipStream_t st) {
  const int R = nseq * T;
  k_copy<<<1024, 256, 0, st>>>(x, hbuf, (size_t)R * D);
  k_rmsnorm<<<R, 256, 0, st>>>(hbuf, in.norm_mix, A);
  k_gemm<0><<<dim3(4096 / 64, R / 64), 256, 0, st>>>(A, in.w_in_hgrn, P, R, 4096, D);
  k_hgrn_recur<<<nseq * H, 128, 0, st>>>(P, in.lb_hgrn, s0, O, S_out, T);
  k_hgrn_out<<<R, 256, 0, st>>>(O, P, in.g_norm_hgrn, A);
  k_gemm<1><<<dim3(D / 64, R / 64), 256, 0, st>>>(A, in.w_out_hgrn, hbuf, R, D, D);
  k_rmsnorm<<<R, 256, 0, st>>>(hbuf, in.norm_mlp, A);
  k_gemm<2><<<dim3(FF / 64, R / 64), 256, 0, st>>>(A, in.w_up, P, R, FF, D);
  k_gemm<1><<<dim3(D / 64, R / 64), 256, 0, st>>>(P, in.w_down, hbuf, R, D, FF);
  k_rmsnorm<<<R, 256, 0, st>>>(hbuf, in.norm_mix + D, A);
  k_gemm<0><<<dim3(3072 / 64, R / 64), 256, 0, st>>>(A, in.w_in_conv, P, R, 3072, D);
  k_conv<<<R, 256, 0, st>>>(P, in.conv_w, cbuf, A, C_out, T);
  k_gemm<1><<<dim3(D / 64, R / 64), 256, 0, st>>>(A, in.w_out_conv, hbuf, R, D, D);
  k_rmsnorm<<<R, 256, 0, st>>>(hbuf, in.norm_mlp + D, A);
  k_gemm<2><<<dim3(FF / 64, R / 64), 256, 0, st>>>(A, in.w_up + (size_t)D * FF, P, R, FF, D);
  k_gemm<1><<<dim3(D / 64, R / 64), 256, 0, st>>>(P, in.w_down + (size_t)FF * D, hbuf, R, D, FF);
  k_rmsnorm<<<R, 256, 0, st>>>(hbuf, in.norm_final, hbuf);
}

static void forward(void* const* d_in, float* out, unsigned char* ws, hipStream_t st) {
  In in{(const float*)d_in[0], (const float*)d_in[1], (const float*)d_in[2], (const float*)d_in[3], (const float*)d_in[4], (const float*)d_in[5], (const float*)d_in[6], (const float*)d_in[7],
        (const float*)d_in[8], (const float*)d_in[9], (const float*)d_in[10], (const float*)d_in[11], (const float*)d_in[12], (const float*)d_in[13], (const float*)d_in[14], (const float*)d_in[15]};
  float* A = (float*)ws; float* P = A + (size_t)4096 * D; float* O = P + (size_t)4096 * 4096;
  float* y_prompt = out; float* y_sample = out + (size_t)32768 * D;
  float* shp = y_sample + (size_t)512 * D; float* scp = shp + (size_t)8 * 8 * 128 * 128; float* shs = scp + (size_t)8 * 2 * D; float* scs = shs + (size_t)16 * 8 * 128 * 128;
  for (int b = 0; b < 8; ++b)
    slab(in, in.x_prompt + (size_t)b * 4096 * D, y_prompt + (size_t)b * 4096 * D, 1, 4096, nullptr, nullptr, shp + (size_t)b * 8 * 128 * 128, scp + (size_t)b * 2 * D, A, P, O, st);
  slab(in, in.x_sample, y_sample, 16, 32, in.state_hgrn, in.state_conv, shs, scs, A, P, O, st);
}
}

#ifndef NV_NO_ENTRY
extern "C" void kernel_launch(void* const* d_in, const int* in_sizes, int n_in, void* d_out, int out_size, void* d_ws, size_t ws_size, hipStream_t stream) {
  nv::forward(d_in, (float*)d_out, (unsigned char*)d_ws, stream);
}
#endif
```

```cpp
#include <hip/hip_runtime.h>
#include <cstdio>
#include <cstdint>

#ifndef DBG_STAGE
#define DBG_STAGE -1
#endif

constexpr int D = 1024, FF = 4096, NH = 8, HD = 128;
constexpr int TP = 4096, NBP = 8, TS = 32, NBS = 16;
constexpr int MP = NBP * TP, MS = NBS * TS, M = MP + MS;
constexpr float EPS = 1e-6f;

constexpr size_t MiB = 1u << 20;
constexpr size_t WS_CTL = 0, CTL_ZERO_BYTES = 1 * MiB;
constexpr size_t WS_LB = 1 * MiB;
constexpr size_t WS_SS = 1 * MiB + 65536;
constexpr size_t WS_DEC = 3 * MiB + 262144;
constexpr size_t WS_W1 = 4 * MiB, WS_W2 = 12 * MiB, WS_W3 = 14 * MiB, WS_W4 = 22 * MiB, WS_W5 = 30 * MiB, WS_W6 = 36 * MiB, WS_W7 = 38 * MiB, WS_W8 = 46 * MiB;
constexpr size_t WS_XA = 54 * MiB, WS_XB = 119 * MiB;
constexpr size_t WS_LOCAL = WS_XB;
constexpr size_t WS_R = 184 * MiB;
constexpr size_t WS_Q = WS_R, WS_V = WS_R + 65 * MiB, WS_SG = WS_R + 130 * MiB, WS_LOGF = WS_R + 195 * MiB;
constexpr size_t WS_HID = WS_R, WS_BG = WS_R, WS_Z = WS_R + 65 * MiB;
constexpr size_t WS_END = 509 * MiB;
static_assert(WS_SS + (size_t)M * 16 * 4 <= WS_DEC && WS_DEC + 1024 * 128 * 4 <= WS_W1, "small buffers");
static_assert((size_t)M * D * 2 == 65 * MiB && (size_t)1024 * 128 * 128 * 4 <= 65 * MiB, "sizes");

constexpr int CW_BAR = 4096;

constexpr int RING_BYTES = 131072, LDSCTL_OFF = RING_BYTES, MISC_OFF = LDSCTL_OFF + 320, LDS_BYTES = 147456;

#define LAS __attribute__((address_space(3)))
typedef unsigned short bf16_t;
typedef short bf16x8 __attribute__((ext_vector_type(8)));
typedef float f32x4 __attribute__((ext_vector_type(4)));
typedef float f32x2 __attribute__((ext_vector_type(2)));
typedef unsigned u32x4 __attribute__((ext_vector_type(4)));
typedef unsigned u32x2 __attribute__((ext_vector_type(2)));

__device__ __forceinline__ unsigned cvt_pk_bf16(float lo, float hi) { unsigned r; asm volatile("v_cvt_pk_bf16_f32 %0, %1, %2" : "=v"(r) : "v"(lo), "v"(hi)); return r; }
__device__ __forceinline__ float bf_lo(unsigned w) { return __builtin_bit_cast(float, w << 16); }
__device__ __forceinline__ float bf_hi(unsigned w) { return __builtin_bit_cast(float, w & 0xffff0000u); }
__device__ __forceinline__ float fexp(float x) { return __builtin_amdgcn_exp2f(x * 1.4426950408889634f); }
__device__ __forceinline__ float flog(float x) { return __builtin_amdgcn_logf(x) * 0.6931471805599453f; }
__device__ __forceinline__ float frcp(float x) { return __builtin_amdgcn_rcpf(x); }
__device__ __forceinline__ float frsq(float x) { return __builtin_amdgcn_rsqf(x); }
#define LDS_WAIT() asm volatile("s_waitcnt lgkmcnt(0)" ::: "memory")

namespace pg8 {
#define PG8_LAS __attribute__((address_space(3)))
constexpr int BM = 256, BK = 64, HALF = 128, HTB = HALF * BK * 2, STAGE_BYTES = 8 * HTB, NXCD = 8, WGM = 8;
__host__ __device__ __forceinline__ int lds_byte(int r, int c) { const int st = (r >> 4) * 2 + (c >> 5), rr = r & 15, cc = c & 31, ob = rr * 64 + cc * 2; return st * 1024 + (ob ^ (((ob >> 9) & 1) << 5)); }
__host__ __device__ __forceinline__ void stage_rc(int b, int& R, int& C) { const int st = b / 1024, sb = b % 1024, swz = sb ^ (((sb >> 9) & 1) << 5); R = (st >> 1) * 16 + swz / 64; C = (st & 1) * 32 + (swz % 64) / 2; }
__host__ __device__ __forceinline__ int perm32(int rho) { const int n = rho >> 4, i = rho & 15; return 8 * (i >> 2) + 4 * n + (i & 3); }

struct Unit { int pm, pn; };
struct Gemm { const bf16_t* A; const bf16_t* Bt; int M, N, K; };

struct StaticOrder {
    int nM, nN, nwg, G, c;
    __host__ __device__ void init(int M_, int N_, int G_, int c_) { nM = M_ / BM; nN = N_ / BM; nwg = nM * nN; G = G_; c = c_; }
    __host__ __device__ bool next(int i, Unit& u) const {
        const long L = (long)i * G + c; if (L >= nwg) return false;
        int wgid = (int)L; { const int q = nwg / NXCD, r = nwg % NXCD, xcd = wgid % NXCD, off = wgid / NXCD; wgid = (xcd < r ? xcd * (q + 1) : r * (q + 1) + (xcd - r) * q) + off; }
        const int nig = WGM * nN, gid = wgid / nig, fm = gid * WGM, gsz = (nM - fm) < WGM ? (nM - fm) : WGM;
        u.pm = fm + ((wgid % nig) % gsz); u.pn = (wgid % nig) / gsz; return true;
    }
    __device__ __forceinline__ void a_ready(const Unit&) const {}
    __device__ __forceinline__ void done(const Unit&) const {}
};

template <class Epi, class Sched, bool ALIGN_EPI = false, bool SP2 = false>
__device__ __forceinline__ void gemm_phase(PG8_LAS unsigned char* lds, const Gemm g, const Sched& S, const Epi& E) {
    const int tid = threadIdx.x, wid = __builtin_amdgcn_readfirstlane(tid >> 6), lane = tid & 63, wr = wid >> 2, wc = wid & 3, fr = lane & 15, fq = lane >> 4;
    const int K = g.K, nt = K / BK;
    unsigned voffA[2], voffB[2];
#pragma unroll
    for (int i = 0; i < 2; ++i) { int R, C; stage_rc(tid * 16 + i * 8192, R, C); const int Rb = Epi::PERM ? ((R & ~31) + perm32(R & 31)) : R;
        voffA[i] = (unsigned)(R * K + C) * 2u; voffB[i] = (unsigned)(Rb * K + C) * 2u; }
    const size_t kstep = (size_t)(BK * 2);
    const size_t hstep = (size_t)HALF * K * 2;
    const size_t tstep = 2 * hstep;
    const unsigned ldsw = (unsigned)wid * 1024u;
    const int aoff = lds_byte(wr * 64 + fr, fq * 8), boff = lds_byte(wc * 32 + fr, fq * 8);
#define PG8_SA(b, h) (((b) * 2 + (h)) * HTB)
#define PG8_SB(b, h) ((4 + (b) * 2 + (h)) * HTB)
#define PG8_STAGE(bufoff, gbase, voff) do { _Pragma("unroll") for (int _i = 0; _i < 2; ++_i) \
        __builtin_amdgcn_global_load_lds((const unsigned*)((const char*)(gbase) + (voff)[_i]), (PG8_LAS unsigned*)(lds + (bufoff) + ldsw + _i * 8192), 16, 0, 0); } while (0)
#define PG8_LDA(dst, b, h) do { _Pragma("unroll") for (int m = 0; m < 4; ++m) _Pragma("unroll") for (int k = 0; k < 2; ++k) dst[m][k] = *(const PG8_LAS bf16x8*)(lds + PG8_SA(b, h) + aoff + m * 2048 + k * 1024); } while (0)
#define PG8_LDB(dst, b, h) do { _Pragma("unroll") for (int n = 0; n < 2; ++n) _Pragma("unroll") for (int k = 0; k < 2; ++k) dst[n][k] = *(const PG8_LAS bf16x8*)(lds + PG8_SB(b, h) + boff + n * 2048 + k * 1024); } while (0)
#define PG8_MMA(ai, bj, At, Bt) do { __builtin_amdgcn_s_setprio(1); _Pragma("unroll") for (int m = 0; m < 4; ++m) _Pragma("unroll") for (int n = 0; n < 2; ++n) _Pragma("unroll") for (int k = 0; k < 2; ++k) \
        acc[ai][bj][m][n] = __builtin_amdgcn_mfma_f32_16x16x32_bf16(Bt[n][k], At[m][k], acc[ai][bj][m][n], 0, 0, 0); __builtin_amdgcn_s_setprio(0); } while (0)
#define PG8_WAIT_V(n) asm volatile("s_waitcnt vmcnt(" #n ")" ::: "memory")
#define PG8_WAIT_L(n) asm volatile("s_waitcnt lgkmcnt(" #n ")" ::: "memory")
#define PG8_BAR __builtin_amdgcn_s_barrier()
#define PG8_SCHED __builtin_amdgcn_sched_barrier(0)
    Unit cur, nxt; int ui = 0;
    if (!S.next(0, cur)) return;
    f32x4 acc[2][2][4][2];
#pragma unroll
    for (int a = 0; a < 2; ++a)
#pragma unroll
        for (int b = 0; b < 2; ++b)
#pragma unroll
            for (int m = 0; m < 4; ++m)
#pragma unroll
                for (int n = 0; n < 2; ++n) acc[a][b][m][n] = (f32x4){0.f, 0.f, 0.f, 0.f};
    bf16x8 At[4][2], B0[2][2], B1[2][2];
    const char* cA = (const char*)g.A + (size_t)cur.pm * tstep; const char* cB = (const char*)g.Bt + (size_t)cur.pn * tstep;
    S.a_ready(cur);
    if constexpr (SP2) {
        PG8_STAGE(PG8_SB(0, 0), cB, voffB); PG8_STAGE(PG8_SB(0, 1), cB + hstep, voffB); PG8_STAGE(PG8_SA(0, 0), cA, voffA); PG8_STAGE(PG8_SA(0, 1), cA + hstep, voffA);
        if (wr == 1) PG8_BAR;
        PG8_WAIT_V(2); PG8_BAR;
        PG8_STAGE(PG8_SB(1, 0), cB + kstep, voffB); PG8_STAGE(PG8_SA(1, 0), cA + kstep, voffA); PG8_STAGE(PG8_SB(1, 1), cB + hstep + kstep, voffB);
        PG8_WAIT_V(6); PG8_BAR;
    } else {
        PG8_STAGE(PG8_SB(0, 0), cB, voffB); PG8_STAGE(PG8_SA(0, 0), cA, voffA); PG8_STAGE(PG8_SB(0, 1), cB + hstep, voffB); PG8_STAGE(PG8_SA(0, 1), cA + hstep, voffA);
        if (wr == 1) PG8_BAR;
        PG8_WAIT_V(4); PG8_BAR;
        PG8_STAGE(PG8_SB(1, 0), cB + kstep, voffB); PG8_STAGE(PG8_SA(1, 0), cA + kstep, voffA); PG8_STAGE(PG8_SB(1, 1), cB + hstep + kstep, voffB);
        PG8_WAIT_V(6); PG8_BAR;
    }
    for (;;) {
        const bool has_next = S.next(ui + 1, nxt);
        const char* nA = has_next ? (const char*)g.A + (size_t)nxt.pm * tstep : cA; const char* nB = has_next ? (const char*)g.Bt + (size_t)nxt.pn * tstep : cB;
        for (int t = 0; t < nt; t += 2) {
            const bool last = (t == nt - 2);
            const char* a1 = cA + (size_t)(t + 1) * kstep;
            const char* a2 = last ? nA : cA + (size_t)(t + 2) * kstep; const char* b2 = last ? nB : cB + (size_t)(t + 2) * kstep;
            const char* a3 = a2 + kstep; const char* b3 = b2 + kstep;
            if (last && has_next) S.a_ready(nxt);
            if constexpr (SP2) {
            PG8_LDB(B0, 0, 0); PG8_LDB(B1, 0, 1); PG8_SCHED; PG8_LDA(At, 0, 0); PG8_STAGE(PG8_SA(1, 1), a1 + hstep, voffA);
            PG8_WAIT_V(8); PG8_WAIT_L(0); PG8_BAR; PG8_MMA(0, 0, At, B0); PG8_MMA(0, 1, At, B1); PG8_BAR; PG8_SCHED;
            PG8_LDA(At, 0, 1); PG8_STAGE(PG8_SB(0, 0), b2, voffB); PG8_STAGE(PG8_SB(0, 1), b2 + hstep, voffB); PG8_STAGE(PG8_SA(0, 0), a2, voffA);
            PG8_WAIT_V(8); PG8_WAIT_L(0); PG8_BAR; PG8_MMA(1, 0, At, B0); PG8_MMA(1, 1, At, B1); PG8_BAR; PG8_SCHED;
            PG8_LDB(B0, 1, 0); PG8_LDB(B1, 1, 1); PG8_SCHED; PG8_LDA(At, 1, 0); PG8_STAGE(PG8_SA(0, 1), a2 + hstep, voffA);
            PG8_WAIT_V(8); PG8_WAIT_L(0); PG8_BAR; PG8_MMA(0, 0, At, B0); PG8_MMA(0, 1, At, B1); PG8_BAR; PG8_SCHED;
            PG8_LDA(At, 1, 1); PG8_STAGE(PG8_SB(1, 0), b3, voffB); PG8_STAGE(PG8_SB(1, 1), b3 + hstep, voffB); PG8_STAGE(PG8_SA(1, 0), a3, voffA);
            PG8_WAIT_V(8); PG8_WAIT_L(0); PG8_BAR; PG8_MMA(1, 0, At, B0); PG8_MMA(1, 1, At, B1); PG8_BAR; PG8_SCHED;
            } else {
            PG8_LDB(B0, 0, 0); PG8_SCHED; PG8_LDA(At, 0, 0); PG8_STAGE(PG8_SA(1, 1), a1 + hstep, voffA);
            PG8_WAIT_L(8); PG8_BAR; PG8_WAIT_L(0); PG8_MMA(0, 0, At, B0); PG8_BAR; PG8_SCHED;
            PG8_LDB(B1, 0, 1); PG8_STAGE(PG8_SB(0, 0), b2, voffB);
            PG8_BAR; PG8_WAIT_L(0); PG8_MMA(0, 1, At, B1); PG8_BAR;
            PG8_LDA(At, 0, 1); PG8_STAGE(PG8_SA(0, 0), a2, voffA);
            PG8_BAR; PG8_WAIT_L(0); PG8_MMA(1, 0, At, B0); PG8_BAR; PG8_SCHED;
            PG8_STAGE(PG8_SB(0, 1), b2 + hstep, voffB);
            PG8_WAIT_V(6); PG8_BAR; PG8_MMA(1, 1, At, B1); PG8_BAR;
            PG8_LDB(B0, 1, 0); PG8_SCHED; PG8_LDA(At, 1, 0); PG8_STAGE(PG8_SA(0, 1), a2 + hstep, voffA);
            PG8_WAIT_L(8); PG8_BAR; PG8_WAIT_L(0); PG8_MMA(0, 0, At, B0); PG8_BAR; PG8_SCHED;
            PG8_LDB(B1, 1, 1); PG8_STAGE(PG8_SB(1, 0), b3, voffB);
            PG8_BAR; PG8_WAIT_L(0); PG8_MMA(0, 1, At, B1); PG8_BAR;
            PG8_LDA(At, 1, 1); PG8_STAGE(PG8_SA(1, 0), a3, voffA);
            PG8_BAR; PG8_WAIT_L(0); PG8_MMA(1, 0, At, B0); PG8_BAR; PG8_SCHED;
            PG8_STAGE(PG8_SB(1, 1), b3 + hstep, voffB);
            PG8_WAIT_V(6); PG8_BAR; PG8_MMA(1, 1, At, B1); PG8_BAR;
            }
        }
        if constexpr (ALIGN_EPI) { if (wr == 0) PG8_BAR; }
        E(acc, cur, wr, wc, fr, fq); S.done(cur);
        if (!has_next) break;
#pragma unroll
        for (int a = 0; a < 2; ++a)
#pragma unroll
            for (int b = 0; b < 2; ++b)
#pragma unroll
                for (int m = 0; m < 4; ++m)
#pragma unroll
                    for (int n = 0; n < 2; ++n) acc[a][b][m][n] = (f32x4){0.f, 0.f, 0.f, 0.f};
        cur = nxt; cA = nA; cB = nB; ++ui;
        if constexpr (ALIGN_EPI) { if (wr == 1) PG8_BAR; }
    }
    PG8_WAIT_V(0);
    if constexpr (!ALIGN_EPI) { if (wr == 0) PG8_BAR; }
    PG8_BAR;
#undef PG8_SA
#undef PG8_SB
#undef PG8_STAGE
#undef PG8_LDA
#undef PG8_LDB
#undef PG8_MMA
#undef PG8_WAIT_V
#undef PG8_WAIT_L
#undef PG8_BAR
#undef PG8_SCHED
}

__device__ __forceinline__ float row_rstd(const float* SS, int row) {
    const f32x4* p = (const f32x4*)(SS + (size_t)row * 16);
    const f32x4 a = p[0], b = p[1], c = p[2], d = p[3];
    const float s = (((a.x + a.y) + (a.z + a.w)) + ((b.x + b.y) + (b.z + b.w))) + (((c.x + c.y) + (c.z + c.w)) + ((d.x + d.y) + (d.z + d.w)));
    return frsq(s * (1.0f / 1024.0f) + EPS);
}
__device__ __forceinline__ u32x4 pack8(const f32x4 v0, const f32x4 v1) { u32x4 w; w.x = cvt_pk_bf16(v0[0], v0[1]); w.y = cvt_pk_bf16(v0[2], v0[3]); w.z = cvt_pk_bf16(v1[0], v1[1]); w.w = cvt_pk_bf16(v1[2], v1[3]); return w; }

struct EpiInProj {
    static constexpr bool PERM = true;
    const float* SS; const float* LB; bf16_t* QVS; float* LOGF;
    __device__ __forceinline__ void operator()(const f32x4 (&acc)[2][2][4][2], const Unit& u, int wr, int wc, int fr, int fq) const {
        const int row0 = u.pm * BM + wr * 64 + fr;
        const int typ = u.pn >> 2;
        const int col0 = (u.pn & 3) * 256 + wc * 32 + 8 * fq;
        float rs[2][4];
#pragma unroll
        for (int ai = 0; ai < 2; ++ai)
#pragma unroll
            for (int m = 0; m < 4; ++m) rs[ai][m] = row_rstd(SS, row0 + ai * HALF + m * 16);
        if (typ == 1) {
            f32x4 lb[2][2];
#pragma unroll
            for (int bj = 0; bj < 2; ++bj)
#pragma unroll
                for (int n = 0; n < 2; ++n) lb[bj][n] = *(const f32x4*)(LB + col0 + bj * HALF + 4 * n);
#pragma unroll
            for (int ai = 0; ai < 2; ++ai)
#pragma unroll
                for (int m = 0; m < 4; ++m) { float* rowp = LOGF + (size_t)(row0 + ai * HALF + m * 16) * D + col0; const float r = rs[ai][m];
#pragma unroll
                    for (int bj = 0; bj < 2; ++bj)
#pragma unroll
                        for (int n = 0; n < 2; ++n) { f32x4 o;
#pragma unroll
                            for (int j = 0; j < 4; ++j) { const float x = acc[ai][bj][m][n][j] * r; const float sg = frcp(1.0f + fexp(-x)); const float l = lb[bj][n][j]; o[j] = flog(l + (1.0f - l) * sg); }
                            *(f32x4*)(rowp + bj * HALF + 4 * n) = o; } }
        } else {
            bf16_t* base = QVS + (size_t)(typ - (typ > 0 ? 1 : 0)) * ((size_t)M * D);
#pragma unroll
            for (int ai = 0; ai < 2; ++ai)
#pragma unroll
                for (int m = 0; m < 4; ++m) { bf16_t* rowp = base + (size_t)(row0 + ai * HALF + m * 16) * D + col0; const float r = rs[ai][m];
#pragma unroll
                    for (int bj = 0; bj < 2; ++bj) { f32x4 v0 = acc[ai][bj][m][0] * r, v1 = acc[ai][bj][m][1] * r;
                        if (typ == 3) {
#pragma unroll
                            for (int j = 0; j < 4; ++j) { v0[j] = v0[j] * frcp(1.0f + fexp(-v0[j])); v1[j] = v1[j] * frcp(1.0f + fexp(-v1[j])); } }
                        *(u32x4*)(rowp + bj * HALF) = pack8(v0, v1); } }
        }
    }
};
struct EpiUp {
    static constexpr bool PERM = true;
    const float* SS; bf16_t* HID;
    __device__ __forceinline__ void operator()(const f32x4 (&acc)[2][2][4][2], const Unit& u, int wr, int wc, int fr, int fq) const {
        const int row0 = u.pm * BM + wr * 64 + fr, col0 = u.pn * BM + wc * 32 + 8 * fq;
#pragma unroll
        for (int ai = 0; ai < 2; ++ai)
#pragma unroll
            for (int m = 0; m < 4; ++m) { const int row = row0 + ai * HALF + m * 16; const float r = row_rstd(SS, row); bf16_t* rowp = HID + (size_t)row * FF + col0;
#pragma unroll
                for (int bj = 0; bj < 2; ++bj) { f32x4 v0 = acc[ai][bj][m][0] * r, v1 = acc[ai][bj][m][1] * r;
#pragma unroll
                    for (int j = 0; j < 4; ++j) { const float a = fmaxf(v0[j], 0.f), b = fmaxf(v1[j], 0.f); v0[j] = a * a; v1[j] = b * b; }
                    *(u32x4*)(rowp + bj * HALF) = pack8(v0, v1); } }
    }
};
struct EpiRes {
    static constexpr bool PERM = true;
    const float* ra; const float* rb; float* H; bf16_t* XO; float* SS;
    __device__ __forceinline__ void operator()(const f32x4 (&acc)[2][2][4][2], const Unit& u, int wr, int wc, int fr, int fq) const {
        const int row0 = u.pm * BM + wr * 64 + fr, col0 = u.pn * BM + wc * 32 + 8 * fq;
#pragma unroll
        for (int ai = 0; ai < 2; ++ai)
#pragma unroll
            for (int m = 0; m < 4; ++m) { const int row = row0 + ai * HALF + m * 16;
                const float* rp = (row < MP ? ra + (size_t)row * D : rb + (size_t)(row - MP) * D) + col0;
                float* hp = H + (size_t)row * D + col0; bf16_t* xp = XO + (size_t)row * D + col0; float ssq = 0.f;
#pragma unroll
                for (int bj = 0; bj < 2; ++bj) { const f32x4 r0 = *(const f32x4*)(rp + bj * HALF), r1 = *(const f32x4*)(rp + bj * HALF + 4);
                    const f32x4 v0 = r0 + acc[ai][bj][m][0], v1 = r1 + acc[ai][bj][m][1];
                    ssq += ((v0[0] * v0[0] + v0[1] * v0[1]) + (v0[2] * v0[2] + v0[3] * v0[3])) + ((v1[0] * v1[0] + v1[1] * v1[1]) + (v1[2] * v1[2] + v1[3] * v1[3]));
                    *(f32x4*)(hp + bj * HALF) = v0; *(f32x4*)(hp + bj * HALF + 4) = v1; *(u32x4*)(xp + bj * HALF) = pack8(v0, v1); }
                ssq += __shfl_xor(ssq, 16); ssq += __shfl_xor(ssq, 32);
                if (fq == 0) SS[(size_t)row * 16 + u.pn * 4 + wc] = ssq;
                asm volatile("" ::: "memory"); }
    }
};
struct EpiConvIn {
    static constexpr bool PERM = true;
    const float* SS; bf16_t* BG; bf16_t* Z; float* scp; float* scs;
    __device__ __forceinline__ void operator()(const f32x4 (&acc)[2][2][4][2], const Unit& u, int wr, int wc, int fr, int fq) const {
        const int row0 = u.pm * BM + wr * 64 + fr;
#pragma unroll
        for (int ai = 0; ai < 2; ++ai)
#pragma unroll
            for (int m = 0; m < 4; ++m) { const int row = row0 + ai * HALF + m * 16; const float r = row_rstd(SS, row);
                if (u.pn < 4) { bf16_t* rowp = BG + (size_t)row * D + u.pn * BM + wc * 32 + 8 * fq;
#pragma unroll
                    for (int bj = 0; bj < 2; ++bj) *(u32x4*)(rowp + bj * HALF) = pack8(acc[ai][bj][m][0] * r, acc[ai][bj][m][1] * r);
                } else { const int col = (u.pn - 4) * 128 + wc * 32 + 8 * fq; const float r2 = r * r;
                    const f32x4 z0 = acc[ai][0][m][0] * acc[ai][1][m][0] * r2, z1 = acc[ai][0][m][1] * acc[ai][1][m][1] * r2;
                    *(u32x4*)(Z + (size_t)row * D + col) = pack8(z0, z1);
                    float* sp = nullptr;
                    if (row < MP) { const int t = row & (TP - 1); if (t >= TP - 2) sp = scp + ((size_t)(row >> 12) * 2 + (t - (TP - 2))) * D + col; }
                    else { const int r2i = row - MP, t = r2i & (TS - 1); if (t >= TS - 2) sp = scs + ((size_t)(r2i >> 5) * 2 + (t - (TS - 2))) * D + col; }
                    if (sp) { *(f32x4*)sp = z0; *(f32x4*)(sp + 4) = z1; } } }
    }
};
}

#define XB_TMO      128
#define XB_XCNT(j)  (256  + 64 * (j))
#define XB_XSUB(j)  (1280 + 64 * (j))
#define XB_XGEN(j)  (2304 + 64 * (j))
#define XB_TOP      3328
#define XB_TOPGEN   3392
#define XCD_BAR_WORDS 3456
#define XB_SPIN_CAP (1u << 18)
__device__ __forceinline__ unsigned xb_ld(unsigned* p)              { return __hip_atomic_load(p, __ATOMIC_RELAXED, __HIP_MEMORY_SCOPE_AGENT); }
__device__ __forceinline__ unsigned xb_add(unsigned* p, unsigned v) { return __hip_atomic_fetch_add(p, v, __ATOMIC_RELAXED, __HIP_MEMORY_SCOPE_AGENT); }
__device__ __forceinline__ unsigned xb_xcc_id() { return (unsigned)__builtin_amdgcn_s_getreg((3 << 11) | 20) & 0xFu; }
#define XB_SPIN(cond, bar) do { unsigned _sp = 0; while (cond) { __builtin_amdgcn_s_sleep(1); \
    if ((++_sp & 255u) == 0u) { if (xb_ld(&(bar)[XB_TMO])) break; if (_sp > XB_SPIN_CAP) { atomicAdd(&(bar)[XB_TMO], 1u); break; } } } } while (0)
struct XcdBarrier { unsigned* bar; unsigned x; volatile LAS unsigned* st; };
__device__ __forceinline__ XcdBarrier xcd_barrier_post(unsigned* bar, volatile LAS unsigned* st) {
    XcdBarrier b; b.bar = bar; b.x = xb_xcc_id(); b.st = st;
    if (threadIdx.x == 0) (void)xb_add(&bar[XB_XCNT(b.x)], 1u);
    return b;
}
__device__ __forceinline__ void xcd_barrier_complete(unsigned* bar, unsigned x, unsigned& nloc, unsigned& nx) {
    const unsigned G = gridDim.x * gridDim.y * gridDim.z;
    unsigned sum, cnt, mine, sp = 0u;
    for (;;) {
        sum = 0u; cnt = 0u; mine = 0u;
#pragma unroll
        for (unsigned j = 0; j < 16; ++j) { const unsigned c = xb_ld(&bar[XB_XCNT(j)]); sum += c; cnt += (c > 0u) ? 1u : 0u; mine = (j == x) ? c : mine; }
        if (sum == G) break;
        __builtin_amdgcn_s_sleep(1);
        if ((++sp & 255u) == 0u) { if (xb_ld(&bar[XB_TMO])) break; if (sp > XB_SPIN_CAP) { atomicAdd(&bar[XB_TMO], 1u); break; } }
    }
    nloc = mine > 0u ? mine : 1u; nx = cnt > 0u ? cnt : 1u;
}
__device__ __forceinline__ void xcd_barrier(const XcdBarrier& b) {
    asm volatile("s_waitcnt vmcnt(0)" ::: "memory");
    __syncthreads();
    if (threadIdx.x == 0) {
        unsigned* bar = b.bar;
        __builtin_amdgcn_s_waitcnt(0);
        unsigned nloc = b.st[0], nx = b.st[1];
        if (nloc == 0u) { xcd_barrier_complete(bar, b.x, nloc, nx); b.st[0] = nloc; b.st[1] = nx; }
        const unsigned old = xb_add(&bar[XB_XSUB(b.x)], 1u);
        const unsigned gen = old / nloc;
        if (old + 1u == (gen + 1u) * nloc) {
            __builtin_amdgcn_fence(__ATOMIC_RELEASE, "agent");
            asm volatile("s_waitcnt vmcnt(0)" ::: "memory");
            const unsigned og = xb_add(&bar[XB_TOP], 1u);
            const unsigned tg = og / nx;
            if (og + 1u == (tg + 1u) * nx) xb_add(&bar[XB_TOPGEN], 1u);
            else XB_SPIN(xb_ld(&bar[XB_TOPGEN]) == tg, bar);
            __builtin_amdgcn_fence(__ATOMIC_ACQUIRE, "agent");
            xb_add(&bar[XB_XGEN(b.x)], 1u);
            asm volatile("s_waitcnt vmcnt(0)" ::: "memory");
        } else {
            XB_SPIN(xb_ld(&bar[XB_XGEN(b.x)]) == gen, bar);
            __builtin_amdgcn_fence(__ATOMIC_ACQUIRE, "agent");
            asm volatile("s_waitcnt vmcnt(0)" ::: "memory");
        }
    }
    __syncthreads();
}

__device__ __forceinline__ float wave_sum(float v) {
#pragma unroll
    for (int o = 1; o < 64; o <<= 1) v += __shfl_xor(v, o);
    return v;
}
__device__ __forceinline__ void p0_transpose_item(const float* W, int K, int Nsrc, int src_n0, const float* gain, bf16_t* WT, int dst_n0, int k0, LAS float* scr, int lane) {
#pragma unroll 8
    for (int i = 0; i < 32; ++i) { const int kk = 2 * i + (lane >> 5); const float gv = gain ? gain[k0 + kk] : 1.0f; scr[kk * 33 + (lane & 31)] = W[(size_t)(k0 + kk) * Nsrc + src_n0 + (lane & 31)] * gv; }
    LDS_WAIT(); asm volatile("" ::: "memory");
    const int c = lane & 7;
#pragma unroll
    for (int j = 0; j < 4; ++j) { const int n = (lane >> 3) + 8 * j; const LAS float* s = scr + (8 * c) * 33 + n;
        u32x4 o; o.x = cvt_pk_bf16(s[0 * 33], s[1 * 33]); o.y = cvt_pk_bf16(s[2 * 33], s[3 * 33]); o.z = cvt_pk_bf16(s[4 * 33], s[5 * 33]); o.w = cvt_pk_bf16(s[6 * 33], s[7 * 33]);
        *(u32x4*)(WT + (size_t)(dst_n0 + n) * K + k0 + 8 * c) = o; }
    LDS_WAIT(); asm volatile("" ::: "memory");
}
template <bool CONVMAP>
__device__ __forceinline__ void p0_matrix(const float* W, int K, int N, const float* gain, bf16_t* WT, LAS float* scr, int gw, int NGW, int lane, int& base) {
    const int nblk = N / 32, nitems = (K / 64) * nblk;
    for (int it = (gw + NGW - (base % NGW)) % NGW; it < nitems; it += NGW) {
        const int kb = it / nblk, nb = it % nblk, dn0 = 32 * nb; int sn0 = dn0;
        if (CONVMAP && dn0 >= 1024) { const int i = (dn0 >> 8) - 4, cc = dn0 & 255; sn0 = 1024 + (cc >> 7) * 1024 + 128 * i + (cc & 127); }
        p0_transpose_item(W, K, N, sn0, gain, WT, dn0, 64 * kb, scr, lane);
    }
    base += nitems;
}

constexpr int R_QT = 0, R_KT = 17408, R_KH = 34816, R_VT = 53248, R_AM = 71680, R_SEG = 80896, R_DD = 82944, R_SSQ = 83456;
constexpr int QS = 136, KS = 72;
#define MFMA16(a, b, c) __builtin_amdgcn_mfma_f32_16x16x32_bf16((a), (b), (c), 0, 0, 0)

template <bool OUT>
__device__ __forceinline__ void recur_item(LAS unsigned char* lds, const int tid, const int wid, const int lane,
                                           const bf16_t* __restrict__ Qg, const float* __restrict__ Lg, const bf16_t* __restrict__ Vg, const bf16_t* __restrict__ SGg,
                                           const int row0, const int ntok, const int nchunk, const int hd,
                                           const float* S_in, float* S_out, float* dec_out, bf16_t* XO) {
    const int fr = lane & 15, fq = lane >> 4, ch = tid & 127, seg = tid >> 7;
    LAS bf16_t* QT = (LAS bf16_t*)(lds + R_QT); LAS bf16_t* KT = (LAS bf16_t*)(lds + R_KT); LAS bf16_t* KH = (LAS bf16_t*)(lds + R_KH);
    LAS bf16_t* VT = (LAS bf16_t*)(lds + R_VT); LAS bf16_t* AM = (LAS bf16_t*)(lds + R_AM);
    LAS float* SEG = (LAS float*)(lds + R_SEG); LAS float* DD = (LAS float*)(lds + R_DD); LAS float* SSQ = (LAS float*)(lds + R_SSQ);
    f32x4 S[8];
#pragma unroll
    for (int i = 0; i < 8; ++i)
#pragma unroll
        for (int j = 0; j < 4; ++j) S[i][j] = S_in ? S_in[(size_t)(16 * i + 4 * fq + j) * HD + 16 * wid + fr] : 0.f;
    float dlog = 0.f;
    const size_t colb = (size_t)hd * HD + ch;
    for (int c = 0; c < nchunk; ++c) {
        const int tok0 = 64 * c;
        float g[16], cs[16]; unsigned short vv[16], qv[16];
#pragma unroll
        for (int i = 0; i < 16; ++i) { const int t = tok0 + 16 * seg + i; const bool ok = t < ntok; const size_t idx = (size_t)(row0 + t) * D + colb;
            g[i] = ok ? Lg[idx] : 0.f; vv[i] = ok ? Vg[idx] : (unsigned short)0; qv[i] = (OUT && ok) ? Qg[idx] : (unsigned short)0; }
        cs[0] = g[0];
#pragma unroll
        for (int i = 1; i < 16; ++i) cs[i] = cs[i - 1] + g[i];
        SEG[seg * 128 + ch] = cs[15];
        __syncthreads();
        float off = 0.f, tot = 0.f;
#pragma unroll
        for (int s = 0; s < 4; ++s) { const float v = SEG[s * 128 + ch]; tot += v; off += (s < seg) ? v : 0.f; }
        const float dtot = fexp(tot);
        if (seg == 0) { DD[ch] = dtot; dlog += tot; }
        float kh[16];
#pragma unroll
        for (int i = 0; i < 16; ++i) { const float b = off + cs[i]; const float e = fexp(b), ie = frcp(e); const float kk = 1.0f - fexp(g[i]);
            if (OUT) { const float q = __builtin_bit_cast(float, (unsigned)qv[i] << 16);
                QT[(16 * seg + i) * QS + ch] = (bf16_t)(cvt_pk_bf16(q * e, 0.f) & 0xffffu); KT[(16 * seg + i) * QS + ch] = (bf16_t)(cvt_pk_bf16(kk * ie, 0.f) & 0xffffu); }
            kh[i] = kk * ie * dtot; }
        { u32x4 w0, w1;
          w0.x = cvt_pk_bf16(kh[0], kh[1]); w0.y = cvt_pk_bf16(kh[2], kh[3]); w0.z = cvt_pk_bf16(kh[4], kh[5]); w0.w = cvt_pk_bf16(kh[6], kh[7]);
          w1.x = cvt_pk_bf16(kh[8], kh[9]); w1.y = cvt_pk_bf16(kh[10], kh[11]); w1.z = cvt_pk_bf16(kh[12], kh[13]); w1.w = cvt_pk_bf16(kh[14], kh[15]);
          *(LAS u32x4*)(KH + ch * KS + 16 * seg) = w0; *(LAS u32x4*)(KH + ch * KS + 16 * seg + 8) = w1;
          u32x4 x0, x1;
          x0.x = (unsigned)vv[0] | ((unsigned)vv[1] << 16); x0.y = (unsigned)vv[2] | ((unsigned)vv[3] << 16); x0.z = (unsigned)vv[4] | ((unsigned)vv[5] << 16); x0.w = (unsigned)vv[6] | ((unsigned)vv[7] << 16);
          x1.x = (unsigned)vv[8] | ((unsigned)vv[9] << 16); x1.y = (unsigned)vv[10] | ((unsigned)vv[11] << 16); x1.z = (unsigned)vv[12] | ((unsigned)vv[13] << 16); x1.w = (unsigned)vv[14] | ((unsigned)vv[15] << 16);
          *(LAS u32x4*)(VT + ch * KS + 16 * seg) = x0; *(LAS u32x4*)(VT + ch * KS + 16 * seg + 8) = x1; }
        __syncthreads();
        if (OUT) {
            const int tt = wid >> 1;
#pragma unroll
            for (int h2 = 0; h2 < 2; ++h2) { const int st = 2 * (wid & 1) + h2; f32x4 a = (f32x4){0.f, 0.f, 0.f, 0.f};
#pragma unroll
                for (int ks = 0; ks < 4; ++ks) { const bf16x8 kf = *(const LAS bf16x8*)(KT + (16 * st + fr) * QS + 32 * ks + 8 * fq); const bf16x8 qf = *(const LAS bf16x8*)(QT + (16 * tt + fr) * QS + 32 * ks + 8 * fq);
                    a = MFMA16(kf, qf, a); }
                const int t = 16 * tt + fr;
#pragma unroll
                for (int j = 0; j < 4; ++j) a[j] = (16 * st + 4 * fq + j <= t) ? a[j] : 0.f;
                u32x2 w; w.x = cvt_pk_bf16(a[0], a[1]); w.y = cvt_pk_bf16(a[2], a[3]);
                *(LAS u32x2*)(AM + t * KS + 16 * st + 4 * fq) = w; }
            __syncthreads();
        }
        bf16x8 vf[2];
#pragma unroll
        for (int ks = 0; ks < 2; ++ks) vf[ks] = *(const LAS bf16x8*)(VT + (16 * wid + fr) * KS + 32 * ks + 8 * fq);
        f32x4 o[4];
        if (OUT) {
            bf16x8 Sb[4];
#pragma unroll
            for (int ks = 0; ks < 4; ++ks) { u32x4 w; w.x = cvt_pk_bf16(S[2 * ks][0], S[2 * ks][1]); w.y = cvt_pk_bf16(S[2 * ks][2], S[2 * ks][3]); w.z = cvt_pk_bf16(S[2 * ks + 1][0], S[2 * ks + 1][1]); w.w = cvt_pk_bf16(S[2 * ks + 1][2], S[2 * ks + 1][3]);
                Sb[ks] = __builtin_bit_cast(bf16x8, w); }
#pragma unroll
            for (int tt = 0; tt < 4; ++tt) { o[tt] = (f32x4){0.f, 0.f, 0.f, 0.f};
#pragma unroll
                for (int ks = 0; ks < 4; ++ks) { const u32x2 lo = *(const LAS u32x2*)(QT + (16 * tt + fr) * QS + 32 * ks + 4 * fq), hi = *(const LAS u32x2*)(QT + (16 * tt + fr) * QS + 32 * ks + 16 + 4 * fq);
                    u32x4 w; w.x = lo.x; w.y = lo.y; w.z = hi.x; w.w = hi.y;
                    o[tt] = MFMA16(Sb[ks], __builtin_bit_cast(bf16x8, w), o[tt]); }
#pragma unroll
                for (int ks = 0; ks < 2; ++ks) { const bf16x8 af = *(const LAS bf16x8*)(AM + (16 * tt + fr) * KS + 32 * ks + 8 * fq); o[tt] = MFMA16(vf[ks], af, o[tt]); } }
        }
#pragma unroll
        for (int i = 0; i < 8; ++i) { const f32x4 dv = *(const LAS f32x4*)(DD + 16 * i + 4 * fq); S[i] = S[i] * dv;
#pragma unroll
            for (int ks = 0; ks < 2; ++ks) { const bf16x8 kf = *(const LAS bf16x8*)(KH + (16 * i + fr) * KS + 32 * ks + 8 * fq); S[i] = MFMA16(kf, vf[ks], S[i]); } }
        if (OUT) {
#pragma unroll
            for (int tt = 0; tt < 4; ++tt) { float p = (o[tt][0] * o[tt][0] + o[tt][1] * o[tt][1]) + (o[tt][2] * o[tt][2] + o[tt][3] * o[tt][3]);
                p += __shfl_xor(p, 16); p += __shfl_xor(p, 32);
                if (fq == 0) SSQ[(16 * tt + fr) * 8 + wid] = p; }
            __syncthreads();
#pragma unroll
            for (int tt = 0; tt < 4; ++tt) { const int t = 16 * tt + fr; const f32x4 a = *(const LAS f32x4*)(SSQ + t * 8), b = *(const LAS f32x4*)(SSQ + t * 8 + 4);
                const float tot2 = ((a.x + a.y) + (a.z + a.w)) + ((b.x + b.y) + (b.z + b.w)); const float r = frsq(tot2 * (1.0f / HD) + EPS);
                const int tk = tok0 + t;
                if (tk < ntok) { const size_t idx = (size_t)(row0 + tk) * D + hd * HD + 16 * wid + 4 * fq; const u32x2 sg = *(const u32x2*)(SGg + idx);
                    u32x2 w; w.x = cvt_pk_bf16(o[tt][0] * r * bf_lo(sg.x), o[tt][1] * r * bf_hi(sg.x)); w.y = cvt_pk_bf16(o[tt][2] * r * bf_lo(sg.y), o[tt][3] * r * bf_hi(sg.y));
                    *(u32x2*)(XO + idx) = w; } }
        }
    }
    if (S_out) {
#pragma unroll
        for (int i = 0; i < 8; ++i)
#pragma unroll
            for (int j = 0; j < 4; ++j) S_out[(size_t)(16 * i + 4 * fq + j) * HD + 16 * wid + fr] = S[i][j];
    }
    if (dec_out && seg == 0) dec_out[ch] = fexp(dlog);
    __syncthreads();
}

struct Args { const float* in[16]; float* outp; unsigned char* wsp; int ph_lo, ph_hi; };
constexpr int N_PHASES = 14;

constexpr size_t O_Y = 0, O_SHP = (size_t)M * D, O_SCP = O_SHP + (size_t)NBP * NH * HD * HD, O_SHS = O_SCP + (size_t)NBP * 2 * D, O_SCS = O_SHS + (size_t)NBS * NH * HD * HD, O_END = O_SCS + (size_t)NBS * 2 * D;

__global__ void __launch_bounds__(512, 2) mk_fwd(Args args) {
    extern __shared__ __attribute__((aligned(16))) unsigned char lds_raw[];
    LAS unsigned char* lds = (LAS unsigned char*)lds_raw;
    volatile LAS unsigned* MISC = (volatile LAS unsigned*)(lds + MISC_OFF);
    const int tid = threadIdx.x, lane = tid & 63, wave = __builtin_amdgcn_readfirstlane(tid >> 6);
    const int G = gridDim.x;
    const int vcu = (G % 8 == 0) ? ((int)blockIdx.x % 8) * (G / 8) + (int)blockIdx.x / 8 : (int)blockIdx.x;
    const int gw = vcu * 8 + wave, NGW = G * 8;
#define ctl ((unsigned*)(args.wsp + WS_CTL))
#define x_prompt (args.in[0])
#define x_sample (args.in[1])
#define state_hgrn (args.in[2])
#define state_conv (args.in[3])
#define norm_mix (args.in[4])
#define norm_mlp (args.in[5])
#define norm_final (args.in[6])
#define w_in_hgrn (args.in[7])
#define lb_hgrn (args.in[8])
#define g_norm_hgrn (args.in[9])
#define w_out_hgrn (args.in[10])
#define w_in_conv (args.in[11])
#define conv_w (args.in[12])
#define w_out_conv (args.in[13])
#define w_up (args.in[14])
#define w_down (args.in[15])
#define out (args.outp)
#define H (args.outp + O_Y)
#define LB ((float*)(args.wsp + WS_LB))
#define SS ((float*)(args.wsp + WS_SS))
#define DEC ((float*)(args.wsp + WS_DEC))
#define W1 ((bf16_t*)(args.wsp + WS_W1))
#define W2 ((bf16_t*)(args.wsp + WS_W2))
#define W3 ((bf16_t*)(args.wsp + WS_W3))
#define W4 ((bf16_t*)(args.wsp + WS_W4))
#define W5 ((bf16_t*)(args.wsp + WS_W5))
#define W6 ((bf16_t*)(args.wsp + WS_W6))
#define W7 ((bf16_t*)(args.wsp + WS_W7))
#define W8 ((bf16_t*)(args.wsp + WS_W8))
#define XA ((bf16_t*)(args.wsp + WS_XA))
#define XB ((bf16_t*)(args.wsp + WS_XB))
#define LOCAL ((float*)(args.wsp + WS_LOCAL))
#define Qb ((bf16_t*)(args.wsp + WS_Q))
#define Vb ((bf16_t*)(args.wsp + WS_V))
#define SGb ((bf16_t*)(args.wsp + WS_SG))
#define LOGF ((float*)(args.wsp + WS_LOGF))
#define HID ((bf16_t*)(args.wsp + WS_HID))
#define BG ((bf16_t*)(args.wsp + WS_BG))
#define Zb ((bf16_t*)(args.wsp + WS_Z))
    for (int u = tid; u < (LDS_BYTES - LDSCTL_OFF) / 4; u += 512) ((LAS unsigned*)(lds + LDSCTL_OFF))[u] = 0u;
    __syncthreads();
    XcdBarrier bar = xcd_barrier_post(ctl + CW_BAR, MISC + 8);
    const int lo = args.ph_lo, hi = args.ph_hi;
#define IN(k) (lo <= (k) && (k) < hi)
#define SEAM(k) do { if (IN(k) && IN((k) + 1)) xcd_barrier(bar); } while (0)

    if (IN(0)) {
        LAS float* scr = (LAS float*)(lds + wave * 16384);
        int base = 0;
        p0_matrix<false>(w_in_hgrn, D, 4 * D, norm_mix, W1, scr, gw, NGW, lane, base);
        p0_matrix<false>(w_out_hgrn, D, D, g_norm_hgrn, W2, scr, gw, NGW, lane, base);
        p0_matrix<false>(w_up, D, FF, norm_mlp, W3, scr, gw, NGW, lane, base);
        p0_matrix<false>(w_down, FF, D, nullptr, W4, scr, gw, NGW, lane, base);
        p0_matrix<true>(w_in_conv, D, 3 * D, norm_mix + D, W5, scr, gw, NGW, lane, base);
        p0_matrix<false>(w_out_conv, D, D, nullptr, W6, scr, gw, NGW, lane, base);
        p0_matrix<false>(w_up + (size_t)D * FF, D, FF, norm_mlp + D, W7, scr, gw, NGW, lane, base);
        p0_matrix<false>(w_down + (size_t)FF * D, FF, D, nullptr, W8, scr, gw, NGW, lane, base);
        if (blockIdx.x == 0) { for (int c = tid; c < D; c += 512) { const float l0 = lb_hgrn[c], l1 = lb_hgrn[D + c]; const float mx = fmaxf(l0, l1); const float e0 = expf(l0 - mx), e1 = expf(l1 - mx); LB[c] = e0 / (e0 + e1); } }
        for (int row = gw; row < M; row += NGW) {
            const float* xr = row < MP ? x_prompt + (size_t)row * D : x_sample + (size_t)(row - MP) * D;
            const f32x4* xp = (const f32x4*)xr + lane; f32x4 v[4]; float s = 0.f;
#pragma unroll
            for (int j = 0; j < 4; ++j) { v[j] = xp[64 * j]; s += (v[j].x * v[j].x + v[j].y * v[j].y) + (v[j].z * v[j].z + v[j].w * v[j].w); }
            s = wave_sum(s);
            u32x2* o8 = (u32x2*)(XB + (size_t)row * D) + lane;
#pragma unroll
            for (int j = 0; j < 4; ++j) { u32x2 w; w.x = cvt_pk_bf16(v[j].x, v[j].y); w.y = cvt_pk_bf16(v[j].z, v[j].w); o8[64 * j] = w; }
            if (lane < 16) SS[(size_t)row * 16 + lane] = lane == 0 ? s : 0.f;
        }
    }
    SEAM(0);
    if (IN(1)) {
        pg8::Gemm g{XB, W1, M, 4 * D, D}; pg8::StaticOrder S; S.init(M, 4 * D, G, (int)blockIdx.x);
        pg8::EpiInProj E{SS, LB, Qb, LOGF};
        pg8::gemm_phase<pg8::EpiInProj, pg8::StaticOrder, true, true>(lds, g, S, E);
    }
    SEAM(1);
    if (IN(2)) {
        for (int it = (int)blockIdx.x; it < 1024; it += G) { const int b = it >> 7, h = (it >> 4) & 7, p = it & 15;
            recur_item<false>(lds, tid, wave, lane, nullptr, LOGF, Vb, nullptr, b * TP + p * 256, 256, 4, h, nullptr, LOCAL + (size_t)it * 16384, DEC + (size_t)it * 128, nullptr); }
    }
    SEAM(2);
    if (IN(3)) {
        for (int e4 = (int)blockIdx.x * 512 + tid; e4 < 64 * 4096; e4 += G * 512) { const int bh = e4 >> 12, e = (e4 & 4095) * 4;
            f32x4 c = (f32x4){0.f, 0.f, 0.f, 0.f};
#pragma unroll 4
            for (int p = 0; p < 16; ++p) { f32x4* lp = (f32x4*)(LOCAL + ((size_t)(bh * 16 + p)) * 16384 + e); const f32x4 L = *lp; const float d = DEC[(size_t)(bh * 16 + p) * 128 + (e >> 7)];
                *lp = c; c = c * d + L; }
            *(f32x4*)(out + O_SHP + (size_t)bh * 16384 + e) = c; }
    }
    SEAM(3);
    if (IN(4)) {
        for (int it = (int)blockIdx.x; it < 1024 + 128; it += G) {
            if (it < 1024) { const int b = it >> 7, h = (it >> 4) & 7, p = it & 15;
                recur_item<true>(lds, tid, wave, lane, Qb, LOGF, Vb, SGb, b * TP + p * 256, 256, 4, h, LOCAL + (size_t)it * 16384, nullptr, nullptr, XA); }
            else { const int j = (it - 1024) >> 3, h = (it - 1024) & 7;
                recur_item<true>(lds, tid, wave, lane, Qb, LOGF, Vb, SGb, MP + j * TS, TS, 1, h, state_hgrn + (size_t)(j * 8 + h) * 16384, out + O_SHS + (size_t)(j * 8 + h) * 16384, nullptr, XA); }
        }
    }
    SEAM(4);
    if (IN(5)) {
        pg8::Gemm g{XA, W2, M, D, D}; pg8::StaticOrder S; S.init(M, D, G, (int)blockIdx.x);
        pg8::EpiRes E{x_prompt, x_sample, H, XB, SS};
        pg8::gemm_phase<pg8::EpiRes, pg8::StaticOrder, true, true>(lds, g, S, E);
    }
    SEAM(5);
    if (IN(6)) {
        pg8::Gemm g{XB, W3, M, FF, D}; pg8::StaticOrder S; S.init(M, FF, G, (int)blockIdx.x);
        pg8::EpiUp E{SS, HID};
        pg8::gemm_phase<pg8::EpiUp, pg8::StaticOrder, true, true>(lds, g, S, E);
    }
    SEAM(6);
    if (IN(7)) {
        pg8::Gemm g{HID, W4, M, D, FF}; pg8::StaticOrder S; S.init(M, D, G, (int)blockIdx.x);
        pg8::EpiRes E{H, H + (size_t)MP * D, H, XA, SS};
        pg8::gemm_phase<pg8::EpiRes, pg8::StaticOrder, true, true>(lds, g, S, E);
    }
    SEAM(7);
    if (IN(8)) {
        pg8::Gemm g{XA, W5, M, 3 * D, D}; pg8::StaticOrder S; S.init(M, 3 * D, G, (int)blockIdx.x);
        pg8::EpiConvIn E{SS, BG, Zb, out + O_SCP, out + O_SCS};
        pg8::gemm_phase<pg8::EpiConvIn, pg8::StaticOrder, true, true>(lds, g, S, E);
    }
    SEAM(8);
    if (IN(9)) {
        for (int row = gw; row < M; row += NGW) {
            int t, sq; if (row < MP) { t = row & (TP - 1); sq = -1; } else { t = (row - MP) & (TS - 1); sq = (row - MP) >> 5; }
#pragma unroll
            for (int j = 0; j < 2; ++j) { const int c0 = 8 * lane + 512 * j;
                const u32x4 bgw = *(const u32x4*)(BG + (size_t)row * D + c0), z0w = *(const u32x4*)(Zb + (size_t)row * D + c0);
                float z1[8], z2[8];
                if (t >= 1) { const u32x4 w = *(const u32x4*)(Zb + (size_t)(row - 1) * D + c0); z1[0] = bf_lo(w.x); z1[1] = bf_hi(w.x); z1[2] = bf_lo(w.y); z1[3] = bf_hi(w.y); z1[4] = bf_lo(w.z); z1[5] = bf_hi(w.z); z1[6] = bf_lo(w.w); z1[7] = bf_hi(w.w); }
                else if (sq >= 0) { const f32x4 a = *(const f32x4*)(state_conv + ((size_t)sq * 2 + 1) * D + c0), b = *(const f32x4*)(state_conv + ((size_t)sq * 2 + 1) * D + c0 + 4); z1[0] = a.x; z1[1] = a.y; z1[2] = a.z; z1[3] = a.w; z1[4] = b.x; z1[5] = b.y; z1[6] = b.z; z1[7] = b.w; }
                else {
#pragma unroll
                    for (int k = 0; k < 8; ++k) z1[k] = 0.f; }
                if (t >= 2) { const u32x4 w = *(const u32x4*)(Zb + (size_t)(row - 2) * D + c0); z2[0] = bf_lo(w.x); z2[1] = bf_hi(w.x); z2[2] = bf_lo(w.y); z2[3] = bf_hi(w.y); z2[4] = bf_lo(w.z); z2[5] = bf_hi(w.z); z2[6] = bf_lo(w.w); z2[7] = bf_hi(w.w); }
                else if (sq >= 0) { const f32x4 a = *(const f32x4*)(state_conv + ((size_t)sq * 2 + t) * D + c0), b = *(const f32x4*)(state_conv + ((size_t)sq * 2 + t) * D + c0 + 4); z2[0] = a.x; z2[1] = a.y; z2[2] = a.z; z2[3] = a.w; z2[4] = b.x; z2[5] = b.y; z2[6] = b.z; z2[7] = b.w; }
                else {
#pragma unroll
                    for (int k = 0; k < 8; ++k) z2[k] = 0.f; }
                const float z0[8] = {bf_lo(z0w.x), bf_hi(z0w.x), bf_lo(z0w.y), bf_hi(z0w.y), bf_lo(z0w.z), bf_hi(z0w.z), bf_lo(z0w.w), bf_hi(z0w.w)};
                const float bg[8] = {bf_lo(bgw.x), bf_hi(bgw.x), bf_lo(bgw.y), bf_hi(bgw.y), bf_lo(bgw.z), bf_hi(bgw.z), bf_lo(bgw.w), bf_hi(bgw.w)};
                const f32x4 wa0 = *(const f32x4*)(conv_w + c0), wa1 = *(const f32x4*)(conv_w + c0 + 4), wb0 = *(const f32x4*)(conv_w + D + c0), wb1 = *(const f32x4*)(conv_w + D + c0 + 4), wc0 = *(const f32x4*)(conv_w + 2 * D + c0), wc1 = *(const f32x4*)(conv_w + 2 * D + c0 + 4);
                const float w0[8] = {wa0.x, wa0.y, wa0.z, wa0.w, wa1.x, wa1.y, wa1.z, wa1.w}, w1[8] = {wb0.x, wb0.y, wb0.z, wb0.w, wb1.x, wb1.y, wb1.z, wb1.w}, w2[8] = {wc0.x, wc0.y, wc0.z, wc0.w, wc1.x, wc1.y, wc1.z, wc1.w};
                float y[8];
#pragma unroll
                for (int k = 0; k < 8; ++k) y[k] = bg[k] * (z2[k] * w0[k] + z1[k] * w1[k] + z0[k] * w2[k]);
                u32x4 o; o.x = cvt_pk_bf16(y[0], y[1]); o.y = cvt_pk_bf16(y[2], y[3]); o.z = cvt_pk_bf16(y[4], y[5]); o.w = cvt_pk_bf16(y[6], y[7]);
                *(u32x4*)(XB + (size_t)row * D + c0) = o; }
        }
    }
    SEAM(9);
    if (IN(10)) {
        pg8::Gemm g{XB, W6, M, D, D}; pg8::StaticOrder S; S.init(M, D, G, (int)blockIdx.x);
        pg8::EpiRes E{H, H + (size_t)MP * D, H, XA, SS};
        pg8::gemm_phase<pg8::EpiRes, pg8::StaticOrder, true, true>(lds, g, S, E);
    }
    SEAM(10);
    if (IN(11)) {
        pg8::Gemm g{XA, W7, M, FF, D}; pg8::StaticOrder S; S.init(M, FF, G, (int)blockIdx.x);
        pg8::EpiUp E{SS, HID};
        pg8::gemm_phase<pg8::EpiUp, pg8::StaticOrder, true, true>(lds, g, S, E);
    }
    SEAM(11);
    if (IN(12)) {
        pg8::Gemm g{HID, W8, M, D, FF}; pg8::StaticOrder S; S.init(M, D, G, (int)blockIdx.x);
        pg8::EpiRes E{H, H + (size_t)MP * D, H, XB, SS};
        pg8::gemm_phase<pg8::EpiRes, pg8::StaticOrder, true, true>(lds, g, S, E);
    }
    SEAM(12);
    if (IN(13)) {
        for (int row = gw; row < M; row += NGW) {
            const float r = pg8::row_rstd(SS, row);
            f32x4* hp = (f32x4*)(H + (size_t)row * D) + lane; const f32x4* gp = (const f32x4*)norm_final + lane;
#pragma unroll
            for (int j = 0; j < 4; ++j) { const f32x4 v = hp[64 * j], gg = gp[64 * j]; hp[64 * j] = v * r * gg; }
        }
    }
#undef IN
#undef SEAM
#undef ctl
#undef x_prompt
#undef x_sample
#undef state_hgrn
#undef state_conv
#undef norm_mix
#undef norm_mlp
#undef norm_final
#undef w_in_hgrn
#undef lb_hgrn
#undef g_norm_hgrn
#undef w_out_hgrn
#undef w_in_conv
#undef conv_w
#undef w_out_conv
#undef w_up
#undef w_down
#undef out
#undef H
#undef LB
#undef SS
#undef DEC
#undef W1
#undef W2
#undef W3
#undef W4
#undef W5
#undef W6
#undef W7
#undef W8
#undef XA
#undef XB
#undef LOCAL
#undef Qb
#undef Vb
#undef SGb
#undef LOGF
#undef HID
#undef BG
#undef Zb
}


extern "C" void kernel_launch(void* const* d_in, const int* in_sizes, int n_in, void* d_out, int out_size, void* d_ws, size_t ws_size, hipStream_t stream) {
    static int grid = 0;
    if (grid == 0) {
        if (n_in != 16 || in_sizes[0] != MP * D || in_sizes[1] != MS * D || (size_t)out_size != O_END || ws_size < WS_END) {
            fprintf(stderr, "kernel_launch: unexpected shapes: n_in %d in0 %d in1 %d out %d ws %zu (need >= %zu); nothing launched\n", n_in, n_in > 0 ? in_sizes[0] : -1, n_in > 1 ? in_sizes[1] : -1, out_size, ws_size, (size_t)WS_END); grid = -1; return; }
        int dev = 0, cus = 0, per_cu = 0;
        if (hipGetDevice(&dev) != hipSuccess || hipDeviceGetAttribute(&cus, hipDeviceAttributeMultiprocessorCount, dev) != hipSuccess) { fprintf(stderr, "kernel_launch: device query failed\n"); grid = -1; return; }
        if (hipFuncSetAttribute((const void*)mk_fwd, hipFuncAttributeMaxDynamicSharedMemorySize, LDS_BYTES) != hipSuccess) { fprintf(stderr, "kernel_launch: hipFuncSetAttribute failed\n"); grid = -1; return; }
        if (hipOccupancyMaxActiveBlocksPerMultiprocessor(&per_cu, (const void*)mk_fwd, 512, LDS_BYTES) != hipSuccess || per_cu < 1) { fprintf(stderr, "kernel_launch: occupancy query says %d blocks per CU\n", per_cu); (void)hipGetLastError(); grid = -1; return; }
        grid = cus;
        fprintf(stderr, "kernel_launch: grid %d (occupancy query %d per CU), ws %zu\n", grid, per_cu, ws_size);
    }
    if (grid < 0) return;
    (void)hipMemsetAsync((char*)d_ws + WS_CTL, 0, CTL_ZERO_BYTES, stream);
    Args a{};
    for (int i = 0; i < 16; ++i) a.in[i] = (const float*)d_in[i];
    a.outp = (float*)d_out; a.wsp = (unsigned char*)d_ws; a.ph_lo = 0;
#if DBG_STAGE >= 1
    a.ph_hi = (DBG_STAGE == 1) ? 2 : DBG_STAGE + 3;
#else
    a.ph_hi = N_PHASES;
#endif
    hipLaunchKernelGGL(mk_fwd, dim3(grid), dim3(512), LDS_BYTES, stream, a);
#if DBG_STAGE >= 1
    nv::forward_from(DBG_STAGE, d_in, (float*)d_out, (unsigned char*)d_ws, stream);
#endif
}
```

```cpp
#include <hip/hip_runtime.h>
#include <cstdio>
#include <cstdint>

#ifndef DBG_STAGE
#define DBG_STAGE -1
#endif

constexpr int D = 1024, FF = 4096, NH = 8, HD = 128;
constexpr int TP = 4096, NBP = 8, TS = 32, NBS = 16;
constexpr int MP = NBP * TP, MS = NBS * TS, M = MP + MS;
constexpr float EPS = 1e-6f;

constexpr size_t MiB = 1u << 20;
constexpr size_t WS_CTL = 0, CTL_ZERO_BYTES = 1 * MiB;
constexpr size_t WS_LB = 1 * MiB;
constexpr size_t WS_SS = 1 * MiB + 65536;
constexpr size_t WS_DEC = 3 * MiB + 262144;
constexpr size_t WS_W1 = 4 * MiB, WS_W2 = 12 * MiB, WS_W3 = 14 * MiB, WS_W4 = 22 * MiB, WS_W5 = 30 * MiB, WS_W6 = 36 * MiB, WS_W7 = 38 * MiB, WS_W8 = 46 * MiB;
constexpr size_t WS_XA = 54 * MiB, WS_XB = 119 * MiB;
constexpr size_t WS_LOCAL = WS_XB;
constexpr size_t WS_R = 184 * MiB;
constexpr size_t WS_Q = WS_R, WS_V = WS_R + 65 * MiB, WS_SG = WS_R + 130 * MiB, WS_LOGF = WS_R + 195 * MiB;
constexpr size_t WS_HID = WS_R, WS_BG = WS_R, WS_Z = WS_R + 65 * MiB;
constexpr size_t WS_END = 509 * MiB;
static_assert(WS_SS + (size_t)M * 16 * 4 <= WS_DEC && WS_DEC + 1024 * 128 * 4 <= WS_W1, "small buffers");
static_assert((size_t)M * D * 2 == 65 * MiB && (size_t)1024 * 128 * 128 * 4 <= 65 * MiB, "sizes");

constexpr int CW_BAR = 4096;

constexpr int RING_BYTES = 131072, LDSCTL_OFF = RING_BYTES, MISC_OFF = LDSCTL_OFF + 320, LDS_BYTES = 147456;

#define LAS __attribute__((address_space(3)))
typedef unsigned short bf16_t;
typedef short bf16x8 __attribute__((ext_vector_type(8)));
typedef float f32x4 __attribute__((ext_vector_type(4)));
typedef float f32x2 __attribute__((ext_vector_type(2)));
typedef unsigned u32x4 __attribute__((ext_vector_type(4)));
typedef unsigned u32x2 __attribute__((ext_vector_type(2)));

__device__ __forceinline__ unsigned cvt_pk_bf16(float lo, float hi) { unsigned r; asm volatile("v_cvt_pk_bf16_f32 %0, %1, %2" : "=v"(r) : "v"(lo), "v"(hi)); return r; }
__device__ __forceinline__ float bf_lo(unsigned w) { return __builtin_bit_cast(float, w << 16); }
__device__ __forceinline__ float bf_hi(unsigned w) { return __builtin_bit_cast(float, w & 0xffff0000u); }
__device__ __forceinline__ float fexp(float x) { return __builtin_amdgcn_exp2f(x * 1.4426950408889634f); }
__device__ __forceinline__ float flog(float x) { return __builtin_amdgcn_logf(x) * 0.6931471805599453f; }
__device__ __forceinline__ float frcp(float x) { return __builtin_amdgcn_rcpf(x); }
__device__ __forceinline__ float frsq(float x) { return __builtin_amdgcn_rsqf(x); }
#define LDS_WAIT() asm volatile("s_waitcnt lgkmcnt(0)" ::: "memory")

namespace pg8 {
#define PG8_LAS __attribute__((address_space(3)))
constexpr int BM = 256, BK = 64, HALF = 128, HTB = HALF * BK * 2, STAGE_BYTES = 8 * HTB, NXCD = 8, WGM = 8;
__host__ __device__ __forceinline__ int lds_byte(int r, int c) { const int st = (r >> 4) * 2 + (c >> 5), rr = r & 15, cc = c & 31, ob = rr * 64 + cc * 2; return st * 1024 + (ob ^ (((ob >> 9) & 1) << 5)); }
__host__ __device__ __forceinline__ void stage_rc(int b, int& R, int& C) { const int st = b / 1024, sb = b % 1024, swz = sb ^ (((sb >> 9) & 1) << 5); R = (st >> 1) * 16 + swz / 64; C = (st & 1) * 32 + (swz % 64) / 2; }
__host__ __device__ __forceinline__ int perm32(int rho) { const int n = rho >> 4, i = rho & 15; return 8 * (i >> 2) + 4 * n + (i & 3); }

struct Unit { int pm, pn; };
struct Gemm { const bf16_t* A; const bf16_t* Bt; int M, N, K; };

struct StaticOrder {
    int nM, nN, nwg, G, c;
    __host__ __device__ void init(int M_, int N_, int G_, int c_) { nM = M_ / BM; nN = N_ / BM; nwg = nM * nN; G = G_; c = c_; }
    __host__ __device__ bool next(int i, Unit& u) const {
        const long L = (long)i * G + c; if (L >= nwg) return false;
        int wgid = (int)L; { const int q = nwg / NXCD, r = nwg % NXCD, xcd = wgid % NXCD, off = wgid / NXCD; wgid = (xcd < r ? xcd * (q + 1) : r * (q + 1) + (xcd - r) * q) + off; }
        const int nig = WGM * nN, gid = wgid / nig, fm = gid * WGM, gsz = (nM - fm) < WGM ? (nM - fm) : WGM;
        u.pm = fm + ((wgid % nig) % gsz); u.pn = (wgid % nig) / gsz; return true;
    }
    __device__ __forceinline__ void a_ready(const Unit&) const {}
    __device__ __forceinline__ void done(const Unit&) const {}
};

template <class Epi, class Sched, bool ALIGN_EPI = false, bool SP2 = false>
__device__ __forceinline__ void gemm_phase(PG8_LAS unsigned char* lds, const Gemm g, const Sched& S, const Epi& E) {
    const int tid = threadIdx.x, wid = __builtin_amdgcn_readfirstlane(tid >> 6), lane = tid & 63, wr = wid >> 2, wc = wid & 3, fr = lane & 15, fq = lane >> 4;
    const int K = g.K, nt = K / BK;
    unsigned voffA[2], voffB[2];
#pragma unroll
    for (int i = 0; i < 2; ++i) { int R, C; stage_rc(tid * 16 + i * 8192, R, C); const int Rb = Epi::PERM ? ((R & ~31) + perm32(R & 31)) : R;
        voffA[i] = (unsigned)(R * K + C) * 2u; voffB[i] = (unsigned)(Rb * K + C) * 2u; }
    const size_t kstep = (size_t)(BK * 2);
    const size_t hstep = (size_t)HALF * K * 2;
    const size_t tstep = 2 * hstep;
    const unsigned ldsw = (unsigned)wid * 1024u;
    const int aoff = lds_byte(wr * 64 + fr, fq * 8), boff = lds_byte(wc * 32 + fr, fq * 8);
#define PG8_SA(b, h) (((b) * 2 + (h)) * HTB)
#define PG8_SB(b, h) ((4 + (b) * 2 + (h)) * HTB)
#define PG8_STAGE(bufoff, gbase, voff) do { _Pragma("unroll") for (int _i = 0; _i < 2; ++_i) \
        __builtin_amdgcn_global_load_lds((const unsigned*)((const char*)(gbase) + (voff)[_i]), (PG8_LAS unsigned*)(lds + (bufoff) + ldsw + _i * 8192), 16, 0, 0); } while (0)
#define PG8_LDA(dst, b, h) do { _Pragma("unroll") for (int m = 0; m < 4; ++m) _Pragma("unroll") for (int k = 0; k < 2; ++k) dst[m][k] = *(const PG8_LAS bf16x8*)(lds + PG8_SA(b, h) + aoff + m * 2048 + k * 1024); } while (0)
#define PG8_LDB(dst, b, h) do { _Pragma("unroll") for (int n = 0; n < 2; ++n) _Pragma("unroll") for (int k = 0; k < 2; ++k) dst[n][k] = *(const PG8_LAS bf16x8*)(lds + PG8_SB(b, h) + boff + n * 2048 + k * 1024); } while (0)
#define PG8_MMA(ai, bj, At, Bt) do { __builtin_amdgcn_s_setprio(1); _Pragma("unroll") for (int m = 0; m < 4; ++m) _Pragma("unroll") for (int n = 0; n < 2; ++n) _Pragma("unroll") for (int k = 0; k < 2; ++k) \
        acc[ai][bj][m][n] = __builtin_amdgcn_mfma_f32_16x16x32_bf16(Bt[n][k], At[m][k], acc[ai][bj][m][n], 0, 0, 0); __builtin_amdgcn_s_setprio(0); } while (0)
#define PG8_WAIT_V(n) asm volatile("s_waitcnt vmcnt(" #n ")" ::: "memory")
#define PG8_WAIT_L(n) asm volatile("s_waitcnt lgkmcnt(" #n ")" ::: "memory")
#define PG8_BAR __builtin_amdgcn_s_barrier()
#define PG8_SCHED __builtin_amdgcn_sched_barrier(0)
    Unit cur, nxt; int ui = 0;
    if (!S.next(0, cur)) return;
    f32x4 acc[2][2][4][2];
#pragma unroll
    for (int a = 0; a < 2; ++a)
#pragma unroll
        for (int b = 0; b < 2; ++b)
#pragma unroll
            for (int m = 0; m < 4; ++m)
#pragma unroll
                for (int n = 0; n < 2; ++n) acc[a][b][m][n] = (f32x4){0.f, 0.f, 0.f, 0.f};
    bf16x8 At[4][2], B0[2][2], B1[2][2];
    const char* cA = (const char*)g.A + (size_t)cur.pm * tstep; const char* cB = (const char*)g.Bt + (size_t)cur.pn * tstep;
    S.a_ready(cur);
    if constexpr (SP2) {
        PG8_STAGE(PG8_SB(0, 0), cB, voffB); PG8_STAGE(PG8_SB(0, 1), cB + hstep, voffB); PG8_STAGE(PG8_SA(0, 0), cA, voffA); PG8_STAGE(PG8_SA(0, 1), cA + hstep, voffA);
        if (wr == 1) PG8_BAR;
        PG8_WAIT_V(2); PG8_BAR;
        PG8_STAGE(PG8_SB(1, 0), cB + kstep, voffB); PG8_STAGE(PG8_SA(1, 0), cA + kstep, voffA); PG8_STAGE(PG8_SB(1, 1), cB + hstep + kstep, voffB);
        PG8_WAIT_V(6); PG8_BAR;
    } else {
        PG8_STAGE(PG8_SB(0, 0), cB, voffB); PG8_STAGE(PG8_SA(0, 0), cA, voffA); PG8_STAGE(PG8_SB(0, 1), cB + hstep, voffB); PG8_STAGE(PG8_SA(0, 1), cA + hstep, voffA);
        if (wr == 1) PG8_BAR;
        PG8_WAIT_V(4); PG8_BAR;
        PG8_STAGE(PG8_SB(1, 0), cB + kstep, voffB); PG8_STAGE(PG8_SA(1, 0), cA + kstep, voffA); PG8_STAGE(PG8_SB(1, 1), cB + hstep + kstep, voffB);
        PG8_WAIT_V(6); PG8_BAR;
    }
    for (;;) {
        const bool has_next = S.next(ui + 1, nxt);
        const char* nA = has_next ? (const char*)g.A + (size_t)nxt.pm * tstep : cA; const char* nB = has_next ? (const char*)g.Bt + (size_t)nxt.pn * tstep : cB;
        for (int t = 0; t < nt; t += 2) {
            const bool last = (t == nt - 2);
            const char* a1 = cA + (size_t)(t + 1) * kstep;
            const char* a2 = last ? nA : cA + (size_t)(t + 2) * kstep; const char* b2 = last ? nB : cB + (size_t)(t + 2) * kstep;
            const char* a3 = a2 + kstep; const char* b3 = b2 + kstep;
            if (last && has_next) S.a_ready(nxt);
            if constexpr (SP2) {
            PG8_LDB(B0, 0, 0); PG8_LDB(B1, 0, 1); PG8_SCHED; PG8_LDA(At, 0, 0); PG8_STAGE(PG8_SA(1, 1), a1 + hstep, voffA);
            PG8_WAIT_V(8); PG8_WAIT_L(0); PG8_BAR; PG8_MMA(0, 0, At, B0); PG8_MMA(0, 1, At, B1); PG8_BAR; PG8_SCHED;
            PG8_LDA(At, 0, 1); PG8_STAGE(PG8_SB(0, 0), b2, voffB); PG8_STAGE(PG8_SB(0, 1), b2 + hstep, voffB); PG8_STAGE(PG8_SA(0, 0), a2, voffA);
            PG8_WAIT_V(8); PG8_WAIT_L(0); PG8_BAR; PG8_MMA(1, 0, At, B0); PG8_MMA(1, 1, At, B1); PG8_BAR; PG8_SCHED;
            PG8_LDB(B0, 1, 0); PG8_LDB(B1, 1, 1); PG8_SCHED; PG8_LDA(At, 1, 0); PG8_STAGE(PG8_SA(0, 1), a2 + hstep, voffA);
            PG8_WAIT_V(8); PG8_WAIT_L(0); PG8_BAR; PG8_MMA(0, 0, At, B0); PG8_MMA(0, 1, At, B1); PG8_BAR; PG8_SCHED;
            PG8_LDA(At, 1, 1); PG8_STAGE(PG8_SB(1, 0), b3, voffB); PG8_STAGE(PG8_SB(1, 1), b3 + hstep, voffB); PG8_STAGE(PG8_SA(1, 0), a3, voffA);
            PG8_WAIT_V(8); PG8_WAIT_L(0); PG8_BAR; PG8_MMA(1, 0, At, B0); PG8_MMA(1, 1, At, B1); PG8_BAR; PG8_SCHED;
            } else {
            PG8_LDB(B0, 0, 0); PG8_SCHED; PG8_LDA(At, 0, 0); PG8_STAGE(PG8_SA(1, 1), a1 + hstep, voffA);
            PG8_WAIT_L(8); PG8_BAR; PG8_WAIT_L(0); PG8_MMA(0, 0, At, B0); PG8_BAR; PG8_SCHED;
            PG8_LDB(B1, 0, 1); PG8_STAGE(PG8_SB(0, 0), b2, voffB);
            PG8_BAR; PG8_WAIT_L(0); PG8_MMA(0, 1, At, B1); PG8_BAR;
            PG8_LDA(At, 0, 1); PG8_STAGE(PG8_SA(0, 0), a2, voffA);
            PG8_BAR; PG8_WAIT_L(0); PG8_MMA(1, 0, At, B0); PG8_BAR; PG8_SCHED;
            PG8_STAGE(PG8_SB(0, 1), b2 + hstep, voffB);
            PG8_WAIT_V(6); PG8_BAR; PG8_MMA(1, 1, At, B1); PG8_BAR;
            PG8_LDB(B0, 1, 0); PG8_SCHED; PG8_LDA(At, 1, 0); PG8_STAGE(PG8_SA(0, 1), a2 + hstep, voffA);
            PG8_WAIT_L(8); PG8_BAR; PG8_WAIT_L(0); PG8_MMA(0, 0, At, B0); PG8_BAR; PG8_SCHED;
            PG8_LDB(B1, 1, 1); PG8_STAGE(PG8_SB(1, 0), b3, voffB);
            PG8_BAR; PG8_WAIT_L(0); PG8_MMA(0, 1, At, B1); PG8_BAR;
            PG8_LDA(At, 1, 1); PG8_STAGE(PG8_SA(1, 0), a3, voffA);
            PG8_BAR; PG8_WAIT_L(0); PG8_MMA(1, 0, At, B0); PG8_BAR; PG8_SCHED;
            PG8_STAGE(PG8_SB(1, 1), b3 + hstep, voffB);
            PG8_WAIT_V(6); PG8_BAR; PG8_MMA(1, 1, At, B1); PG8_BAR;
            }
        }
        if constexpr (ALIGN_EPI) { if (wr == 0) PG8_BAR; }
        E(acc, cur, wr, wc, fr, fq); S.done(cur);
        if (!has_next) break;
#pragma unroll
        for (int a = 0; a < 2; ++a)
#pragma unroll
            for (int b = 0; b < 2; ++b)
#pragma unroll
                for (int m = 0; m < 4; ++m)
#pragma unroll
                    for (int n = 0; n < 2; ++n) acc[a][b][m][n] = (f32x4){0.f, 0.f, 0.f, 0.f};
        cur = nxt; cA = nA; cB = nB; ++ui;
        if constexpr (ALIGN_EPI) { if (wr == 1) PG8_BAR; }
    }
    PG8_WAIT_V(0);
    if constexpr (!ALIGN_EPI) { if (wr == 0) PG8_BAR; }
    PG8_BAR;
#undef PG8_SA
#undef PG8_SB
#undef PG8_STAGE
#undef PG8_LDA
#undef PG8_LDB
#undef PG8_MMA
#undef PG8_WAIT_V
#undef PG8_WAIT_L
#undef PG8_BAR
#undef PG8_SCHED
}

__device__ __forceinline__ float row_rstd(const float* SS, int row) {
    const f32x4* p = (const f32x4*)(SS + (size_t)row * 16);
    const f32x4 a = p[0], b = p[1], c = p[2], d = p[3];
    const float s = (((a.x + a.y) + (a.z + a.w)) + ((b.x + b.y) + (b.z + b.w))) + (((c.x + c.y) + (c.z + c.w)) + ((d.x + d.y) + (d.z + d.w)));
    return frsq(s * (1.0f / 1024.0f) + EPS);
}
__device__ __forceinline__ u32x4 pack8(const f32x4 v0, const f32x4 v1) { u32x4 w; w.x = cvt_pk_bf16(v0[0], v0[1]); w.y = cvt_pk_bf16(v0[2], v0[3]); w.z = cvt_pk_bf16(v1[0], v1[1]); w.w = cvt_pk_bf16(v1[2], v1[3]); return w; }

struct EpiInProj {
    static constexpr bool PERM = true;
    const float* SS; const float* LB; bf16_t* QVS; float* LOGF;
    __device__ __forceinline__ void operator()(const f32x4 (&acc)[2][2][4][2], const Unit& u, int wr, int wc, int fr, int fq) const {
        const int row0 = u.pm * BM + wr * 64 + fr;
        const int typ = u.pn >> 2;
        const int col0 = (u.pn & 3) * 256 + wc * 32 + 8 * fq;
        float rs[2][4];
#pragma unroll
        for (int ai = 0; ai < 2; ++ai)
#pragma unroll
            for (int m = 0; m < 4; ++m) rs[ai][m] = row_rstd(SS, row0 + ai * HALF + m * 16);
        if (typ == 1) {
            f32x4 lb[2][2];
#pragma unroll
            for (int bj = 0; bj < 2; ++bj)
#pragma unroll
                for (int n = 0; n < 2; ++n) lb[bj][n] = *(const f32x4*)(LB + col0 + bj * HALF + 4 * n);
#pragma unroll
            for (int ai = 0; ai < 2; ++ai)
#pragma unroll
                for (int m = 0; m < 4; ++m) { float* rowp = LOGF + (size_t)(row0 + ai * HALF + m * 16) * D + col0; const float r = rs[ai][m];
#pragma unroll
                    for (int bj = 0; bj < 2; ++bj)
#pragma unroll
                        for (int n = 0; n < 2; ++n) { f32x4 o;
#pragma unroll
                            for (int j = 0; j < 4; ++j) { const float x = acc[ai][bj][m][n][j] * r; const float sg = frcp(1.0f + fexp(-x)); const float l = lb[bj][n][j]; o[j] = flog(l + (1.0f - l) * sg); }
                            *(f32x4*)(rowp + bj * HALF + 4 * n) = o; } }
        } else {
            bf16_t* base = QVS + (size_t)(typ - (typ > 0 ? 1 : 0)) * ((size_t)M * D);
#pragma unroll
            for (int ai = 0; ai < 2; ++ai)
#pragma unroll
                for (int m = 0; m < 4; ++m) { bf16_t* rowp = base + (size_t)(row0 + ai * HALF + m * 16) * D + col0; const float r = rs[ai][m];
#pragma unroll
                    for (int bj = 0; bj < 2; ++bj) { f32x4 v0 = acc[ai][bj][m][0] * r, v1 = acc[ai][bj][m][1] * r;
                        if (typ == 3) {
#pragma unroll
                            for (int j = 0; j < 4; ++j) { v0[j] = v0[j] * frcp(1.0f + fexp(-v0[j])); v1[j] = v1[j] * frcp(1.0f + fexp(-v1[j])); } }
                        *(u32x4*)(rowp + bj * HALF) = pack8(v0, v1); } }
        }
    }
};
struct EpiUp {
    static constexpr bool PERM = true;
    const float* SS; bf16_t* HID;
    __device__ __forceinline__ void operator()(const f32x4 (&acc)[2][2][4][2], const Unit& u, int wr, int wc, int fr, int fq) const {
        const int row0 = u.pm * BM + wr * 64 + fr, col0 = u.pn * BM + wc * 32 + 8 * fq;
#pragma unroll
        for (int ai = 0; ai < 2; ++ai)
#pragma unroll
            for (int m = 0; m < 4; ++m) { const int row = row0 + ai * HALF + m * 16; const float r = row_rstd(SS, row); bf16_t* rowp = HID + (size_t)row * FF + col0;
#pragma unroll
                for (int bj = 0; bj < 2; ++bj) { f32x4 v0 = acc[ai][bj][m][0] * r, v1 = acc[ai][bj][m][1] * r;
#pragma unroll
                    for (int j = 0; j < 4; ++j) { const float a = fmaxf(v0[j], 0.f), b = fmaxf(v1[j], 0.f); v0[j] = a * a; v1[j] = b * b; }
                    *(u32x4*)(rowp + bj * HALF) = pack8(v0, v1); } }
    }
};
struct EpiRes {
    static constexpr bool PERM = true;
    const float* ra; const float* rb; float* H; bf16_t* XO; float* SS;
    __device__ __forceinline__ void operator()(const f32x4 (&acc)[2][2][4][2], const Unit& u, int wr, int wc, int fr, int fq) const {
        const int row0 = u.pm * BM + wr * 64 + fr, col0 = u.pn * BM + wc * 32 + 8 * fq;
#pragma unroll
        for (int ai = 0; ai < 2; ++ai)
#pragma unroll
            for (int m = 0; m < 4; ++m) { const int row = row0 + ai * HALF + m * 16;
                const float* rp = (row < MP ? ra + (size_t)row * D : rb + (size_t)(row - MP) * D) + col0;
                float* hp = H + (size_t)row * D + col0; bf16_t* xp = XO + (size_t)row * D + col0; float ssq = 0.f;
#pragma unroll
                for (int bj = 0; bj < 2; ++bj) { const f32x4 r0 = *(const f32x4*)(rp + bj * HALF), r1 = *(const f32x4*)(rp + bj * HALF + 4);
                    const f32x4 v0 = r0 + acc[ai][bj][m][0], v1 = r1 + acc[ai][bj][m][1];
                    ssq += ((v0[0] * v0[0] + v0[1] * v0[1]) + (v0[2] * v0[2] + v0[3] * v0[3])) + ((v1[0] * v1[0] + v1[1] * v1[1]) + (v1[2] * v1[2] + v1[3] * v1[3]));
                    *(f32x4*)(hp + bj * HALF) = v0; *(f32x4*)(hp + bj * HALF + 4) = v1; *(u32x4*)(xp + bj * HALF) = pack8(v0, v1); }
                ssq += __shfl_xor(ssq, 16); ssq += __shfl_xor(ssq, 32);
                if (fq == 0) SS[(size_t)row * 16 + u.pn * 4 + wc] = ssq;
                asm volatile("" ::: "memory"); }
    }
};
struct EpiConvIn {
    static constexpr bool PERM = true;
    const float* SS; bf16_t* BG; bf16_t* Z; float* scp; float* scs;
    __device__ __forceinline__ void operator()(const f32x4 (&acc)[2][2][4][2], const Unit& u, int wr, int wc, int fr, int fq) const {
        const int row0 = u.pm * BM + wr * 64 + fr;
#pragma unroll
        for (int ai = 0; ai < 2; ++ai)
#pragma unroll
            for (int m = 0; m < 4; ++m) { const int row = row0 + ai * HALF + m * 16; const float r = row_rstd(SS, row);
                if (u.pn < 4) { bf16_t* rowp = BG + (size_t)row * D + u.pn * BM + wc * 32 + 8 * fq;
#pragma unroll
                    for (int bj = 0; bj < 2; ++bj) *(u32x4*)(rowp + bj * HALF) = pack8(acc[ai][bj][m][0] * r, acc[ai][bj][m][1] * r);
                } else { const int col = (u.pn - 4) * 128 + wc * 32 + 8 * fq; const float r2 = r * r;
                    const f32x4 z0 = acc[ai][0][m][0] * acc[ai][1][m][0] * r2, z1 = acc[ai][0][m][1] * acc[ai][1][m][1] * r2;
                    *(u32x4*)(Z + (size_t)row * D + col) = pack8(z0, z1);
                    float* sp = nullptr;
                    if (row < MP) { const int t = row & (TP - 1); if (t >= TP - 2) sp = scp + ((size_t)(row >> 12) * 2 + (t - (TP - 2))) * D + col; }
                    else { const int r2i = row - MP, t = r2i & (TS - 1); if (t >= TS - 2) sp = scs + ((size_t)(r2i >> 5) * 2 + (t - (TS - 2))) * D + col; }
                    if (sp) { *(f32x4*)sp = z0; *(f32x4*)(sp + 4) = z1; } } }
    }
};
}

#define XB_TMO      128
#define XB_XCNT(j)  (256  + 64 * (j))
#define XB_XSUB(j)  (1280 + 64 * (j))
#define XB_XGEN(j)  (2304 + 64 * (j))
#define XB_TOP      3328
#define XB_TOPGEN   3392
#define XCD_BAR_WORDS 3456
#define XB_SPIN_CAP (1u << 18)
__device__ __forceinline__ unsigned xb_ld(unsigned* p)              { return __hip_atomic_load(p, __ATOMIC_RELAXED, __HIP_MEMORY_SCOPE_AGENT); }
__device__ __forceinline__ unsigned xb_add(unsigned* p, unsigned v) { return __hip_atomic_fetch_add(p, v, __ATOMIC_RELAXED, __HIP_MEMORY_SCOPE_AGENT); }
__device__ __forceinline__ unsigned xb_xcc_id() { return (unsigned)__builtin_amdgcn_s_getreg((3 << 11) | 20) & 0xFu; }
#define XB_SPIN(cond, bar) do { unsigned _sp = 0; while (cond) { __builtin_amdgcn_s_sleep(1); \
    if ((++_sp & 255u) == 0u) { if (xb_ld(&(bar)[XB_TMO])) break; if (_sp > XB_SPIN_CAP) { atomicAdd(&(bar)[XB_TMO], 1u); break; } } } } while (0)
struct XcdBarrier { unsigned* bar; unsigned x; volatile LAS unsigned* st; };
__device__ __forceinline__ XcdBarrier xcd_barrier_post(unsigned* bar, volatile LAS unsigned* st) {
    XcdBarrier b; b.bar = bar; b.x = xb_xcc_id(); b.st = st;
    if (threadIdx.x == 0) (void)xb_add(&bar[XB_XCNT(b.x)], 1u);
    return b;
}
__device__ __forceinline__ void xcd_barrier_complete(unsigned* bar, unsigned x, unsigned& nloc, unsigned& nx) {
    const unsigned G = gridDim.x * gridDim.y * gridDim.z;
    unsigned sum, cnt, mine, sp = 0u;
    for (;;) {
        sum = 0u; cnt = 0u; mine = 0u;
#pragma unroll
        for (unsigned j = 0; j < 16; ++j) { const unsigned c = xb_ld(&bar[XB_XCNT(j)]); sum += c; cnt += (c > 0u) ? 1u : 0u; mine = (j == x) ? c : mine; }
        if (sum == G) break;
        __builtin_amdgcn_s_sleep(1);
        if ((++sp & 255u) == 0u) { if (xb_ld(&bar[XB_TMO])) break; if (sp > XB_SPIN_CAP) { atomicAdd(&bar[XB_TMO], 1u); break; } }
    }
    nloc = mine > 0u ? mine : 1u; nx = cnt > 0u ? cnt : 1u;
}
__device__ __forceinline__ void xcd_barrier(const XcdBarrier& b) {
    asm volatile("s_waitcnt vmcnt(0)" ::: "memory");
    __syncthreads();
    if (threadIdx.x == 0) {
        unsigned* bar = b.bar;
        __builtin_amdgcn_s_waitcnt(0);
        unsigned nloc = b.st[0], nx = b.st[1];
        if (nloc == 0u) { xcd_barrier_complete(bar, b.x, nloc, nx); b.st[0] = nloc; b.st[1] = nx; }
        const unsigned old = xb_add(&bar[XB_XSUB(b.x)], 1u);
        const unsigned gen = old / nloc;
        if (old + 1u == (gen + 1u) * nloc) {
            __builtin_amdgcn_fence(__ATOMIC_RELEASE, "agent");
            asm volatile("s_waitcnt vmcnt(0)" ::: "memory");
            const unsigned og = xb_add(&bar[XB_TOP], 1u);
            const unsigned tg = og / nx;
            if (og + 1u == (tg + 1u) * nx) xb_add(&bar[XB_TOPGEN], 1u);
            else XB_SPIN(xb_ld(&bar[XB_TOPGEN]) == tg, bar);
            __builtin_amdgcn_fence(__ATOMIC_ACQUIRE, "agent");
            xb_add(&bar[XB_XGEN(b.x)], 1u);
            asm volatile("s_waitcnt vmcnt(0)" ::: "memory");
        } else {
            XB_SPIN(xb_ld(&bar[XB_XGEN(b.x)]) == gen, bar);
            __builtin_amdgcn_fence(__ATOMIC_ACQUIRE, "agent");
            asm volatile("s_waitcnt vmcnt(0)" ::: "memory");
        }
    }
    __syncthreads();
}

__device__ __forceinline__ float wave_sum(float v) {
#pragma unroll
    for (int o = 1; o < 64; o <<= 1) v += __shfl_xor(v, o);
    return v;
}
__device__ __forceinline__ void p0_transpose_item(const float* W, int K, int Nsrc, int src_n0, const float* gain, bf16_t* WT, int dst_n0, int k0, LAS float* scr, int lane) {
#pragma unroll 8
    for (int i = 0; i < 32; ++i) { const int kk = 2 * i + (lane >> 5); const float gv = gain ? gain[k0 + kk] : 1.0f; scr[kk * 33 + (lane & 31)] = W[(size_t)(k0 + kk) * Nsrc + src_n0 + (lane & 31)] * gv; }
    LDS_WAIT(); asm volatile("" ::: "memory");
    const int c = lane & 7;
#pragma unroll
    for (int j = 0; j < 4; ++j) { const int n = (lane >> 3) + 8 * j; const LAS float* s = scr + (8 * c) * 33 + n;
        u32x4 o; o.x = cvt_pk_bf16(s[0 * 33], s[1 * 33]); o.y = cvt_pk_bf16(s[2 * 33], s[3 * 33]); o.z = cvt_pk_bf16(s[4 * 33], s[5 * 33]); o.w = cvt_pk_bf16(s[6 * 33], s[7 * 33]);
        *(u32x4*)(WT + (size_t)(dst_n0 + n) * K + k0 + 8 * c) = o; }
    LDS_WAIT(); asm volatile("" ::: "memory");
}
template <bool CONVMAP>
__device__ __forceinline__ void p0_matrix(const float* W, int K, int N, const float* gain, bf16_t* WT, LAS float* scr, int gw, int NGW, int lane, int& base) {
    const int nblk = N / 32, nitems = (K / 64) * nblk;
    for (int it = (gw + NGW - (base % NGW)) % NGW; it < nitems; it += NGW) {
        const int kb = it / nblk, nb = it % nblk, dn0 = 32 * nb; int sn0 = dn0;
        if (CONVMAP && dn0 >= 1024) { const int i = (dn0 >> 8) - 4, cc = dn0 & 255; sn0 = 1024 + (cc >> 7) * 1024 + 128 * i + (cc & 127); }
        p0_transpose_item(W, K, N, sn0, gain, WT, dn0, 64 * kb, scr, lane);
    }
    base += nitems;
}

constexpr int R_QT = 0, R_KT = 17408, R_KH = 34816, R_VT = 53248, R_AM = 71680, R_SEG = 80896, R_DD = 82944, R_SSQ = 83456;
constexpr int QS = 136, KS = 72;
#define MFMA16(a, b, c) __builtin_amdgcn_mfma_f32_16x16x32_bf16((a), (b), (c), 0, 0, 0)

template <bool OUT>
__device__ __forceinline__ void recur_item(LAS unsigned char* lds, const int tid, const int wid, const int lane,
                                           const bf16_t* __restrict__ Qg, const float* __restrict__ Lg, const bf16_t* __restrict__ Vg, const bf16_t* __restrict__ SGg,
                                           const int row0, const int ntok, const int nchunk, const int hd,
                                           const float* S_in, float* S_out, float* dec_out, bf16_t* XO) {
    const int fr = lane & 15, fq = lane >> 4, ch = tid & 127, seg = tid >> 7;
    LAS bf16_t* QT = (LAS bf16_t*)(lds + R_QT); LAS bf16_t* KT = (LAS bf16_t*)(lds + R_KT); LAS bf16_t* KH = (LAS bf16_t*)(lds + R_KH);
    LAS bf16_t* VT = (LAS bf16_t*)(lds + R_VT); LAS bf16_t* AM = (LAS bf16_t*)(lds + R_AM);
    LAS float* SEG = (LAS float*)(lds + R_SEG); LAS float* DD = (LAS float*)(lds + R_DD); LAS float* SSQ = (LAS float*)(lds + R_SSQ);
    f32x4 S[8];
#pragma unroll
    for (int i = 0; i < 8; ++i)
#pragma unroll
        for (int j = 0; j < 4; ++j) S[i][j] = S_in ? S_in[(size_t)(16 * i + 4 * fq + j) * HD + 16 * wid + fr] : 0.f;
    float dlog = 0.f;
    const size_t colb = (size_t)hd * HD + ch;
    for (int c = 0; c < nchunk; ++c) {
        const int tok0 = 64 * c;
        float g[16], cs[16]; unsigned short vv[16], qv[16];
#pragma unroll
        for (int i = 0; i < 16; ++i) { const int t = tok0 + 16 * seg + i; const bool ok = t < ntok; const size_t idx = (size_t)(row0 + (ok ? t : ntok - 1)) * D + colb;
            const float gl = Lg[idx]; const unsigned short vl = Vg[idx]; const unsigned short ql = OUT ? Qg[idx] : (unsigned short)0;
            g[i] = ok ? gl : 0.f; vv[i] = ok ? vl : (unsigned short)0; qv[i] = ok ? ql : (unsigned short)0; }
        cs[0] = g[0];
#pragma unroll
        for (int i = 1; i < 16; ++i) cs[i] = cs[i - 1] + g[i];
        SEG[seg * 128 + ch] = cs[15];
        __syncthreads();
        float off = 0.f, tot = 0.f;
#pragma unroll
        for (int s = 0; s < 4; ++s) { const float v = SEG[s * 128 + ch]; tot += v; off += (s < seg) ? v : 0.f; }
        const float dtot = fexp(tot);
        if (seg == 0) { DD[ch] = dtot; dlog += tot; }
        float kh[16];
#pragma unroll
        for (int i = 0; i < 16; ++i) { const float b = off + cs[i]; const float e = fexp(b), ie = frcp(e); const float kk = 1.0f - fexp(g[i]);
            if (OUT) { const float q = __builtin_bit_cast(float, (unsigned)qv[i] << 16);
                QT[(16 * seg + i) * QS + ch] = (bf16_t)(cvt_pk_bf16(q * e, 0.f) & 0xffffu); KT[(16 * seg + i) * QS + ch] = (bf16_t)(cvt_pk_bf16(kk * ie, 0.f) & 0xffffu); }
            kh[i] = kk * ie * dtot; }
        { u32x4 w0, w1;
          w0.x = cvt_pk_bf16(kh[0], kh[1]); w0.y = cvt_pk_bf16(kh[2], kh[3]); w0.z = cvt_pk_bf16(kh[4], kh[5]); w0.w = cvt_pk_bf16(kh[6], kh[7]);
          w1.x = cvt_pk_bf16(kh[8], kh[9]); w1.y = cvt_pk_bf16(kh[10], kh[11]); w1.z = cvt_pk_bf16(kh[12], kh[13]); w1.w = cvt_pk_bf16(kh[14], kh[15]);
          *(LAS u32x4*)(KH + ch * KS + 16 * seg) = w0; *(LAS u32x4*)(KH + ch * KS + 16 * seg + 8) = w1;
          u32x4 x0, x1;
          x0.x = (unsigned)vv[0] | ((unsigned)vv[1] << 16); x0.y = (unsigned)vv[2] | ((unsigned)vv[3] << 16); x0.z = (unsigned)vv[4] | ((unsigned)vv[5] << 16); x0.w = (unsigned)vv[6] | ((unsigned)vv[7] << 16);
          x1.x = (unsigned)vv[8] | ((unsigned)vv[9] << 16); x1.y = (unsigned)vv[10] | ((unsigned)vv[11] << 16); x1.z = (unsigned)vv[12] | ((unsigned)vv[13] << 16); x1.w = (unsigned)vv[14] | ((unsigned)vv[15] << 16);
          *(LAS u32x4*)(VT + ch * KS + 16 * seg) = x0; *(LAS u32x4*)(VT + ch * KS + 16 * seg + 8) = x1; }
        __syncthreads();
        if (OUT) {
            const int tt = wid >> 1;
#pragma unroll
            for (int h2 = 0; h2 < 2; ++h2) { const int st = 2 * (wid & 1) + h2; f32x4 a = (f32x4){0.f, 0.f, 0.f, 0.f};
#pragma unroll
                for (int ks = 0; ks < 4; ++ks) { const bf16x8 kf = *(const LAS bf16x8*)(KT + (16 * st + fr) * QS + 32 * ks + 8 * fq); const bf16x8 qf = *(const LAS bf16x8*)(QT + (16 * tt + fr) * QS + 32 * ks + 8 * fq);
                    a = MFMA16(kf, qf, a); }
                const int t = 16 * tt + fr;
#pragma unroll
                for (int j = 0; j < 4; ++j) a[j] = (16 * st + 4 * fq + j <= t) ? a[j] : 0.f;
                u32x2 w; w.x = cvt_pk_bf16(a[0], a[1]); w.y = cvt_pk_bf16(a[2], a[3]);
                *(LAS u32x2*)(AM + t * KS + 16 * st + 4 * fq) = w; }
            __syncthreads();
        }
        bf16x8 vf[2];
#pragma unroll
        for (int ks = 0; ks < 2; ++ks) vf[ks] = *(const LAS bf16x8*)(VT + (16 * wid + fr) * KS + 32 * ks + 8 * fq);
        f32x4 o[4];
        if (OUT) {
            bf16x8 Sb[4];
#pragma unroll
            for (int ks = 0; ks < 4; ++ks) { u32x4 w; w.x = cvt_pk_bf16(S[2 * ks][0], S[2 * ks][1]); w.y = cvt_pk_bf16(S[2 * ks][2], S[2 * ks][3]); w.z = cvt_pk_bf16(S[2 * ks + 1][0], S[2 * ks + 1][1]); w.w = cvt_pk_bf16(S[2 * ks + 1][2], S[2 * ks + 1][3]);
                Sb[ks] = __builtin_bit_cast(bf16x8, w); }
#pragma unroll
            for (int tt = 0; tt < 4; ++tt) { o[tt] = (f32x4){0.f, 0.f, 0.f, 0.f};
#pragma unroll
                for (int ks = 0; ks < 4; ++ks) { const u32x2 lo = *(const LAS u32x2*)(QT + (16 * tt + fr) * QS + 32 * ks + 4 * fq), hi = *(const LAS u32x2*)(QT + (16 * tt + fr) * QS + 32 * ks + 16 + 4 * fq);
                    u32x4 w; w.x = lo.x; w.y = lo.y; w.z = hi.x; w.w = hi.y;
                    o[tt] = MFMA16(Sb[ks], __builtin_bit_cast(bf16x8, w), o[tt]); }
#pragma unroll
                for (int ks = 0; ks < 2; ++ks) { const bf16x8 af = *(const LAS bf16x8*)(AM + (16 * tt + fr) * KS + 32 * ks + 8 * fq); o[tt] = MFMA16(vf[ks], af, o[tt]); } }
        }
#pragma unroll
        for (int i = 0; i < 8; ++i) { const f32x4 dv = *(const LAS f32x4*)(DD + 16 * i + 4 * fq); S[i] = S[i] * dv;
#pragma unroll
            for (int ks = 0; ks < 2; ++ks) { const bf16x8 kf = *(const LAS bf16x8*)(KH + (16 * i + fr) * KS + 32 * ks + 8 * fq); S[i] = MFMA16(kf, vf[ks], S[i]); } }
        if (OUT) {
#pragma unroll
            for (int tt = 0; tt < 4; ++tt) { float p = (o[tt][0] * o[tt][0] + o[tt][1] * o[tt][1]) + (o[tt][2] * o[tt][2] + o[tt][3] * o[tt][3]);
                p += __shfl_xor(p, 16); p += __shfl_xor(p, 32);
                if (fq == 0) SSQ[(16 * tt + fr) * 8 + wid] = p; }
            __syncthreads();
#pragma unroll
            for (int tt = 0; tt < 4; ++tt) { const int t = 16 * tt + fr; const f32x4 a = *(const LAS f32x4*)(SSQ + t * 8), b = *(const LAS f32x4*)(SSQ + t * 8 + 4);
                const float tot2 = ((a.x + a.y) + (a.z + a.w)) + ((b.x + b.y) + (b.z + b.w)); const float r = frsq(tot2 * (1.0f / HD) + EPS);
                const int tk = tok0 + t;
                if (tk < ntok) { const size_t idx = (size_t)(row0 + tk) * D + hd * HD + 16 * wid + 4 * fq; const u32x2 sg = *(const u32x2*)(SGg + idx);
                    u32x2 w; w.x = cvt_pk_bf16(o[tt][0] * r * bf_lo(sg.x), o[tt][1] * r * bf_hi(sg.x)); w.y = cvt_pk_bf16(o[tt][2] * r * bf_lo(sg.y), o[tt][3] * r * bf_hi(sg.y));
                    *(u32x2*)(XO + idx) = w; } }
        }
    }
    if (S_out) {
#pragma unroll
        for (int i = 0; i < 8; ++i)
#pragma unroll
            for (int j = 0; j < 4; ++j) S_out[(size_t)(16 * i + 4 * fq + j) * HD + 16 * wid + fr] = S[i][j];
    }
    if (dec_out && seg == 0) dec_out[ch] = fexp(dlog);
    __syncthreads();
}

struct Args { const float* in[16]; float* outp; unsigned char* wsp; int ph_lo, ph_hi; };
constexpr int N_PHASES = 14;

constexpr size_t O_Y = 0, O_SHP = (size_t)M * D, O_SCP = O_SHP + (size_t)NBP * NH * HD * HD, O_SHS = O_SCP + (size_t)NBP * 2 * D, O_SCS = O_SHS + (size_t)NBS * NH * HD * HD, O_END = O_SCS + (size_t)NBS * 2 * D;

__global__ void __launch_bounds__(512, 2) mk_fwd(Args args) {
    extern __shared__ __attribute__((aligned(16))) unsigned char lds_raw[];
    LAS unsigned char* lds = (LAS unsigned char*)lds_raw;
    volatile LAS unsigned* MISC = (volatile LAS unsigned*)(lds + MISC_OFF);
    const int tid = threadIdx.x, lane = tid & 63, wave = __builtin_amdgcn_readfirstlane(tid >> 6);
    const int G = gridDim.x;
    const int vcu = (G % 8 == 0) ? ((int)blockIdx.x % 8) * (G / 8) + (int)blockIdx.x / 8 : (int)blockIdx.x;
    const int gw = vcu * 8 + wave, NGW = G * 8;
#define ctl ((unsigned*)(args.wsp + WS_CTL))
#define x_prompt (args.in[0])
#define x_sample (args.in[1])
#define state_hgrn (args.in[2])
#define state_conv (args.in[3])
#define norm_mix (args.in[4])
#define norm_mlp (args.in[5])
#define norm_final (args.in[6])
#define w_in_hgrn (args.in[7])
#define lb_hgrn (args.in[8])
#define g_norm_hgrn (args.in[9])
#define w_out_hgrn (args.in[10])
#define w_in_conv (args.in[11])
#define conv_w (args.in[12])
#define w_out_conv (args.in[13])
#define w_up (args.in[14])
#define w_down (args.in[15])
#define out (args.outp)
#define H (args.outp + O_Y)
#define LB ((float*)(args.wsp + WS_LB))
#define SS ((float*)(args.wsp + WS_SS))
#define DEC ((float*)(args.wsp + WS_DEC))
#define W1 ((bf16_t*)(args.wsp + WS_W1))
#define W2 ((bf16_t*)(args.wsp + WS_W2))
#define W3 ((bf16_t*)(args.wsp + WS_W3))
#define W4 ((bf16_t*)(args.wsp + WS_W4))
#define W5 ((bf16_t*)(args.wsp + WS_W5))
#define W6 ((bf16_t*)(args.wsp + WS_W6))
#define W7 ((bf16_t*)(args.wsp + WS_W7))
#define W8 ((bf16_t*)(args.wsp + WS_W8))
#define XA ((bf16_t*)(args.wsp + WS_XA))
#define XB ((bf16_t*)(args.wsp + WS_XB))
#define LOCAL ((float*)(args.wsp + WS_LOCAL))
#define Qb ((bf16_t*)(args.wsp + WS_Q))
#define Vb ((bf16_t*)(args.wsp + WS_V))
#define SGb ((bf16_t*)(args.wsp + WS_SG))
#define LOGF ((float*)(args.wsp + WS_LOGF))
#define HID ((bf16_t*)(args.wsp + WS_HID))
#define BG ((bf16_t*)(args.wsp + WS_BG))
#define Zb ((bf16_t*)(args.wsp + WS_Z))
    for (int u = tid; u < (LDS_BYTES - LDSCTL_OFF) / 4; u += 512) ((LAS unsigned*)(lds + LDSCTL_OFF))[u] = 0u;
    __syncthreads();
    XcdBarrier bar = xcd_barrier_post(ctl + CW_BAR, MISC + 8);
    const int lo = args.ph_lo, hi = args.ph_hi;
#define IN(k) (lo <= (k) && (k) < hi)
#define SEAM(k) do { if (IN(k) && IN((k) + 1)) xcd_barrier(bar); } while (0)
#ifndef DUP_PHASE
#define DUP_PHASE -1
#endif
#define PH_BEGIN(k) if (IN(k)) { for (int rep_ = 0; rep_ < ((k) == DUP_PHASE ? 2 : 1); ++rep_) { if (rep_) xcd_barrier(bar);
#define PH_END(k) } }

    PH_BEGIN(0)
        LAS float* scr = (LAS float*)(lds + wave * 16384);
        int base = 0;
        p0_matrix<false>(w_in_hgrn, D, 4 * D, norm_mix, W1, scr, gw, NGW, lane, base);
        p0_matrix<false>(w_out_hgrn, D, D, g_norm_hgrn, W2, scr, gw, NGW, lane, base);
        p0_matrix<false>(w_up, D, FF, norm_mlp, W3, scr, gw, NGW, lane, base);
        p0_matrix<false>(w_down, FF, D, nullptr, W4, scr, gw, NGW, lane, base);
        p0_matrix<true>(w_in_conv, D, 3 * D, norm_mix + D, W5, scr, gw, NGW, lane, base);
        p0_matrix<false>(w_out_conv, D, D, nullptr, W6, scr, gw, NGW, lane, base);
        p0_matrix<false>(w_up + (size_t)D * FF, D, FF, norm_mlp + D, W7, scr, gw, NGW, lane, base);
        p0_matrix<false>(w_down + (size_t)FF * D, FF, D, nullptr, W8, scr, gw, NGW, lane, base);
        if (blockIdx.x == 0) { for (int c = tid; c < D; c += 512) { const float l0 = lb_hgrn[c], l1 = lb_hgrn[D + c]; const float mx = fmaxf(l0, l1); const float e0 = expf(l0 - mx), e1 = expf(l1 - mx); LB[c] = e0 / (e0 + e1); } }
        for (int row = gw; row < M; row += NGW) {
            const float* xr = row < MP ? x_prompt + (size_t)row * D : x_sample + (size_t)(row - MP) * D;
            const f32x4* xp = (const f32x4*)xr + lane; f32x4 v[4]; float s = 0.f;
#pragma unroll
            for (int j = 0; j < 4; ++j) { v[j] = xp[64 * j]; s += (v[j].x * v[j].x + v[j].y * v[j].y) + (v[j].z * v[j].z + v[j].w * v[j].w); }
            s = wave_sum(s);
            u32x2* o8 = (u32x2*)(XB + (size_t)row * D) + lane;
#pragma unroll
            for (int j = 0; j < 4; ++j) { u32x2 w; w.x = cvt_pk_bf16(v[j].x, v[j].y); w.y = cvt_pk_bf16(v[j].z, v[j].w); o8[64 * j] = w; }
            if (lane < 16) SS[(size_t)row * 16 + lane] = lane == 0 ? s : 0.f;
        }
    PH_END(0)
    SEAM(0);
    PH_BEGIN(1)
        pg8::Gemm g{XB, W1, M, 4 * D, D}; pg8::StaticOrder S; S.init(M, 4 * D, G, (int)blockIdx.x);
        pg8::EpiInProj E{SS, LB, Qb, LOGF};
        pg8::gemm_phase<pg8::EpiInProj, pg8::StaticOrder, true, true>(lds, g, S, E);
    PH_END(1)
    SEAM(1);
    PH_BEGIN(2)
        for (int it = (int)blockIdx.x; it < 1024; it += G) { const int b = it >> 7, h = (it >> 4) & 7, p = it & 15;
            recur_item<false>(lds, tid, wave, lane, nullptr, LOGF, Vb, nullptr, b * TP + p * 256, 256, 4, h, nullptr, LOCAL + (size_t)it * 16384, DEC + (size_t)it * 128, nullptr); }
    PH_END(2)
    SEAM(2);
    PH_BEGIN(3)
        for (int e4 = (int)blockIdx.x * 512 + tid; e4 < 64 * 4096; e4 += G * 512) { const int bh = e4 >> 12, e = (e4 & 4095) * 4;
            f32x4 c = (f32x4){0.f, 0.f, 0.f, 0.f};
#pragma unroll 4
            for (int p = 0; p < 16; ++p) { f32x4* lp = (f32x4*)(LOCAL + ((size_t)(bh * 16 + p)) * 16384 + e); const f32x4 L = *lp; const float d = DEC[(size_t)(bh * 16 + p) * 128 + (e >> 7)];
                *lp = c; c = c * d + L; }
            *(f32x4*)(out + O_SHP + (size_t)bh * 16384 + e) = c; }
    PH_END(3)
    SEAM(3);
    PH_BEGIN(4)
        for (int it = (int)blockIdx.x; it < 1024 + 128; it += G) {
            if (it < 1024) { const int b = it >> 7, h = (it >> 4) & 7, p = it & 15;
                recur_item<true>(lds, tid, wave, lane, Qb, LOGF, Vb, SGb, b * TP + p * 256, 256, 4, h, LOCAL + (size_t)it * 16384, nullptr, nullptr, XA); }
            else { const int j = (it - 1024) >> 3, h = (it - 1024) & 7;
                recur_item<true>(lds, tid, wave, lane, Qb, LOGF, Vb, SGb, MP + j * TS, TS, 1, h, state_hgrn + (size_t)(j * 8 + h) * 16384, out + O_SHS + (size_t)(j * 8 + h) * 16384, nullptr, XA); }
        }
    PH_END(4)
    SEAM(4);
    PH_BEGIN(5)
        pg8::Gemm g{XA, W2, M, D, D}; pg8::StaticOrder S; S.init(M, D, G, (int)blockIdx.x);
        pg8::EpiRes E{x_prompt, x_sample, H, XB, SS};
        pg8::gemm_phase<pg8::EpiRes, pg8::StaticOrder, true, true>(lds, g, S, E);
    PH_END(5)
    SEAM(5);
    PH_BEGIN(6)
        pg8::Gemm g{XB, W3, M, FF, D}; pg8::StaticOrder S; S.init(M, FF, G, (int)blockIdx.x);
        pg8::EpiUp E{SS, HID};
        pg8::gemm_phase<pg8::EpiUp, pg8::StaticOrder, true, true>(lds, g, S, E);
    PH_END(6)
    SEAM(6);
    PH_BEGIN(7)
        pg8::Gemm g{HID, W4, M, D, FF}; pg8::StaticOrder S; S.init(M, D, G, (int)blockIdx.x);
        pg8::EpiRes E{H, H + (size_t)MP * D, H, XA, SS};
        pg8::gemm_phase<pg8::EpiRes, pg8::StaticOrder, true, true>(lds, g, S, E);
    PH_END(7)
    SEAM(7);
    PH_BEGIN(8)
        pg8::Gemm g{XA, W5, M, 3 * D, D}; pg8::StaticOrder S; S.init(M, 3 * D, G, (int)blockIdx.x);
        pg8::EpiConvIn E{SS, BG, Zb, out + O_SCP, out + O_SCS};
        pg8::gemm_phase<pg8::EpiConvIn, pg8::StaticOrder, true, true>(lds, g, S, E);
    PH_END(8)
    SEAM(8);
    PH_BEGIN(9)
        for (int row = gw; row < M; row += NGW) {
            int t, sq; if (row < MP) { t = row & (TP - 1); sq = -1; } else { t = (row - MP) & (TS - 1); sq = (row - MP) >> 5; }
#pragma unroll
            for (int j = 0; j < 2; ++j) { const int c0 = 8 * lane + 512 * j;
                const u32x4 bgw = *(const u32x4*)(BG + (size_t)row * D + c0), z0w = *(const u32x4*)(Zb + (size_t)row * D + c0);
                float z1[8], z2[8];
                if (t >= 1) { const u32x4 w = *(const u32x4*)(Zb + (size_t)(row - 1) * D + c0); z1[0] = bf_lo(w.x); z1[1] = bf_hi(w.x); z1[2] = bf_lo(w.y); z1[3] = bf_hi(w.y); z1[4] = bf_lo(w.z); z1[5] = bf_hi(w.z); z1[6] = bf_lo(w.w); z1[7] = bf_hi(w.w); }
                else if (sq >= 0) { const f32x4 a = *(const f32x4*)(state_conv + ((size_t)sq * 2 + 1) * D + c0), b = *(const f32x4*)(state_conv + ((size_t)sq * 2 + 1) * D + c0 + 4); z1[0] = a.x; z1[1] = a.y; z1[2] = a.z; z1[3] = a.w; z1[4] = b.x; z1[5] = b.y; z1[6] = b.z; z1[7] = b.w; }
                else {
#pragma unroll
                    for (int k = 0; k < 8; ++k) z1[k] = 0.f; }
                if (t >= 2) { const u32x4 w = *(const u32x4*)(Zb + (size_t)(row - 2) * D + c0); z2[0] = bf_lo(w.x); z2[1] = bf_hi(w.x); z2[2] = bf_lo(w.y); z2[3] = bf_hi(w.y); z2[4] = bf_lo(w.z); z2[5] = bf_hi(w.z); z2[6] = bf_lo(w.w); z2[7] = bf_hi(w.w); }
                else if (sq >= 0) { const f32x4 a = *(const f32x4*)(state_conv + ((size_t)sq * 2 + t) * D + c0), b = *(const f32x4*)(state_conv + ((size_t)sq * 2 + t) * D + c0 + 4); z2[0] = a.x; z2[1] = a.y; z2[2] = a.z; z2[3] = a.w; z2[4] = b.x; z2[5] = b.y; z2[6] = b.z; z2[7] = b.w; }
                else {
#pragma unroll
                    for (int k = 0; k < 8; ++k) z2[k] = 0.f; }
                const float z0[8] = {bf_lo(z0w.x), bf_hi(z0w.x), bf_lo(z0w.y), bf_hi(z0w.y), bf_lo(z0w.z), bf_hi(z0w.z), bf_lo(z0w.w), bf_hi(z0w.w)};
                const float bg[8] = {bf_lo(bgw.x), bf_hi(bgw.x), bf_lo(bgw.y), bf_hi(bgw.y), bf_lo(bgw.z), bf_hi(bgw.z), bf_lo(bgw.w), bf_hi(bgw.w)};
                const f32x4 wa0 = *(const f32x4*)(conv_w + c0), wa1 = *(const f32x4*)(conv_w + c0 + 4), wb0 = *(const f32x4*)(conv_w + D + c0), wb1 = *(const f32x4*)(conv_w + D + c0 + 4), wc0 = *(const f32x4*)(conv_w + 2 * D + c0), wc1 = *(const f32x4*)(conv_w + 2 * D + c0 + 4);
                const float w0[8] = {wa0.x, wa0.y, wa0.z, wa0.w, wa1.x, wa1.y, wa1.z, wa1.w}, w1[8] = {wb0.x, wb0.y, wb0.z, wb0.w, wb1.x, wb1.y, wb1.z, wb1.w}, w2[8] = {wc0.x, wc0.y, wc0.z, wc0.w, wc1.x, wc1.y, wc1.z, wc1.w};
                float y[8];
#pragma unroll
                for (int k = 0; k < 8; ++k) y[k] = bg[k] * (z2[k] * w0[k] + z1[k] * w1[k] + z0[k] * w2[k]);
                u32x4 o; o.x = cvt_pk_bf16(y[0], y[1]); o.y = cvt_pk_bf16(y[2], y[3]); o.z = cvt_pk_bf16(y[4], y[5]); o.w = cvt_pk_bf16(y[6], y[7]);
                *(u32x4*)(XB + (size_t)row * D + c0) = o; }
        }
    PH_END(9)
    SEAM(9);
    PH_BEGIN(10)
        pg8::Gemm g{XB, W6, M, D, D}; pg8::StaticOrder S; S.init(M, D, G, (int)blockIdx.x);
        pg8::EpiRes E{H, H + (size_t)MP * D, H, XA, SS};
        pg8::gemm_phase<pg8::EpiRes, pg8::StaticOrder, true, true>(lds, g, S, E);
    PH_END(10)
    SEAM(10);
    PH_BEGIN(11)
        pg8::Gemm g{XA, W7, M, FF, D}; pg8::StaticOrder S; S.init(M, FF, G, (int)blockIdx.x);
        pg8::EpiUp E{SS, HID};
        pg8::gemm_phase<pg8::EpiUp, pg8::StaticOrder, true, true>(lds, g, S, E);
    PH_END(11)
    SEAM(11);
    PH_BEGIN(12)
        pg8::Gemm g{HID, W8, M, D, FF}; pg8::StaticOrder S; S.init(M, D, G, (int)blockIdx.x);
        pg8::EpiRes E{H, H + (size_t)MP * D, H, XB, SS};
        pg8::gemm_phase<pg8::EpiRes, pg8::StaticOrder, true, true>(lds, g, S, E);
    PH_END(12)
    SEAM(12);
    PH_BEGIN(13)
        for (int row = gw; row < M; row += NGW) {
            const float r = pg8::row_rstd(SS, row);
            f32x4* hp = (f32x4*)(H + (size_t)row * D) + lane; const f32x4* gp = (const f32x4*)norm_final + lane;
#pragma unroll
            for (int j = 0; j < 4; ++j) { const f32x4 v = hp[64 * j], gg = gp[64 * j]; hp[64 * j] = v * r * gg; }
        }
    PH_END(13)
#undef IN
#undef SEAM
#undef ctl
#undef x_prompt
#undef x_sample
#undef state_hgrn
#undef state_conv
#undef norm_mix
#undef norm_mlp
#undef norm_final
#undef w_in_hgrn
#undef lb_hgrn
#undef g_norm_hgrn
#undef w_out_hgrn
#undef w_in_conv
#undef conv_w
#undef w_out_conv
#undef w_up
#undef w_down
#undef out
#undef H
#undef LB
#undef SS
#undef DEC
#undef W1
#undef W2
#undef W3
#undef W4
#undef W5
#undef W6
#undef W7
#undef W8
#undef XA
#undef XB
#undef LOCAL
#undef Qb
#undef Vb
#undef SGb
#undef LOGF
#undef HID
#undef BG
#undef Zb
}


extern "C" void kernel_launch(void* const* d_in, const int* in_sizes, int n_in, void* d_out, int out_size, void* d_ws, size_t ws_size, hipStream_t stream) {
    static int grid = 0;
    if (grid == 0) {
        if (n_in != 16 || in_sizes[0] != MP * D || in_sizes[1] != MS * D || (size_t)out_size != O_END || ws_size < WS_END) {
            fprintf(stderr, "kernel_launch: unexpected shapes: n_in %d in0 %d in1 %d out %d ws %zu (need >= %zu); nothing launched\n", n_in, n_in > 0 ? in_sizes[0] : -1, n_in > 1 ? in_sizes[1] : -1, out_size, ws_size, (size_t)WS_END); grid = -1; return; }
        int dev = 0, cus = 0, per_cu = 0;
        if (hipGetDevice(&dev) != hipSuccess || hipDeviceGetAttribute(&cus, hipDeviceAttributeMultiprocessorCount, dev) != hipSuccess) { fprintf(stderr, "kernel_launch: device query failed\n"); grid = -1; return; }
        if (hipFuncSetAttribute((const void*)mk_fwd, hipFuncAttributeMaxDynamicSharedMemorySize, LDS_BYTES) != hipSuccess) { fprintf(stderr, "kernel_launch: hipFuncSetAttribute failed\n"); grid = -1; return; }
        if (hipOccupancyMaxActiveBlocksPerMultiprocessor(&per_cu, (const void*)mk_fwd, 512, LDS_BYTES) != hipSuccess || per_cu < 1) { fprintf(stderr, "kernel_launch: occupancy query says %d blocks per CU\n", per_cu); (void)hipGetLastError(); grid = -1; return; }
        grid = cus;
        fprintf(stderr, "kernel_launch: grid %d (occupancy query %d per CU), ws %zu\n", grid, per_cu, ws_size);
    }
    if (grid < 0) return;
    (void)hipMemsetAsync((char*)d_ws + WS_CTL, 0, CTL_ZERO_BYTES, stream);
    Args a{};
    for (int i = 0; i < 16; ++i) a.in[i] = (const float*)d_in[i];
    a.outp = (float*)d_out; a.wsp = (unsigned char*)d_ws; a.ph_lo = 0;
#if DBG_STAGE >= 1
    a.ph_hi = (DBG_STAGE == 1) ? 2 : DBG_STAGE + 3;
#else
    a.ph_hi = N_PHASES;
#endif
    hipLaunchKernelGGL(mk_fwd, dim3(grid), dim3(512), LDS_BYTES, stream, a);
#if DBG_STAGE >= 1
    nv::forward_from(DBG_STAGE, d_in, (float*)d_out, (unsigned char*)d_ws, stream);
#endif
}
```

```cpp
#include <hip/hip_runtime.h>
#include <cstdio>
#include <cstdint>

#ifndef DBG_STAGE
#define DBG_STAGE -1
#endif

constexpr int D = 1024, FF = 4096, NH = 8, HD = 128;
constexpr int TP = 4096, NBP = 8, TS = 32, NBS = 16;
constexpr int MP = NBP * TP, MS = NBS * TS, M = MP + MS;
constexpr float EPS = 1e-6f;

constexpr size_t MiB = 1u << 20;
constexpr size_t WS_CTL = 0, CTL_ZERO_BYTES = 1 * MiB;
constexpr size_t WS_LB = 1 * MiB;
constexpr size_t WS_SS = 1 * MiB + 65536;
constexpr size_t WS_DEC = 3 * MiB + 262144;
constexpr size_t WS_W1 = 4 * MiB, WS_W2 = 12 * MiB, WS_W3 = 14 * MiB, WS_W4 = 22 * MiB, WS_W5 = 30 * MiB, WS_W6 = 36 * MiB, WS_W7 = 38 * MiB, WS_W8 = 46 * MiB;
constexpr size_t WS_XA = 54 * MiB, WS_XB = 119 * MiB;
constexpr size_t WS_LOCAL = WS_XB;
constexpr size_t WS_R = 184 * MiB;
constexpr size_t WS_Q = WS_R, WS_V = WS_R + 65 * MiB, WS_SG = WS_R + 130 * MiB, WS_LOGF = WS_R + 195 * MiB;
constexpr size_t WS_HID = WS_R, WS_BG = WS_R, WS_Z = WS_R + 65 * MiB;
constexpr size_t WS_END = 444 * MiB;
static_assert(WS_SS + (size_t)M * 16 * 4 <= WS_DEC && WS_DEC + 1024 * 128 * 4 <= WS_W1, "small buffers");
static_assert((size_t)M * D * 2 == 65 * MiB && (size_t)1024 * 128 * 128 * 4 <= 65 * MiB, "sizes");

constexpr int CW_BAR = 4096;

constexpr int RING_BYTES = 131072, LDSCTL_OFF = RING_BYTES, MISC_OFF = LDSCTL_OFF + 320, LDS_BYTES = 147456;

#define LAS __attribute__((address_space(3)))
typedef unsigned short bf16_t;
typedef short bf16x8 __attribute__((ext_vector_type(8)));
typedef float f32x4 __attribute__((ext_vector_type(4)));
typedef float f32x2 __attribute__((ext_vector_type(2)));
typedef unsigned u32x4 __attribute__((ext_vector_type(4)));
typedef unsigned u32x2 __attribute__((ext_vector_type(2)));

__device__ __forceinline__ unsigned cvt_pk_bf16(float lo, float hi) { unsigned r; asm volatile("v_cvt_pk_bf16_f32 %0, %1, %2" : "=v"(r) : "v"(lo), "v"(hi)); return r; }
__device__ __forceinline__ float bf_lo(unsigned w) { return __builtin_bit_cast(float, w << 16); }
__device__ __forceinline__ float bf_hi(unsigned w) { return __builtin_bit_cast(float, w & 0xffff0000u); }
__device__ __forceinline__ float fexp(float x) { return __builtin_amdgcn_exp2f(x * 1.4426950408889634f); }
__device__ __forceinline__ float flog(float x) { return __builtin_amdgcn_logf(x) * 0.6931471805599453f; }
__device__ __forceinline__ float frcp(float x) { return __builtin_amdgcn_rcpf(x); }
__device__ __forceinline__ float frsq(float x) { return __builtin_amdgcn_rsqf(x); }
typedef _Float16 f16x2 __attribute__((ext_vector_type(2)));
__device__ __forceinline__ unsigned pk_f16(float lo, float hi) { f16x2 v; v.x = (_Float16)lo; v.y = (_Float16)hi; return __builtin_bit_cast(unsigned, v); }
__device__ __forceinline__ float h_lo(unsigned w) { return (float)__builtin_bit_cast(f16x2, w).x; }
__device__ __forceinline__ float h_hi(unsigned w) { return (float)__builtin_bit_cast(f16x2, w).y; }
#define LDS_WAIT() asm volatile("s_waitcnt lgkmcnt(0)" ::: "memory")

namespace pg8 {
#define PG8_LAS __attribute__((address_space(3)))
constexpr int BM = 256, BK = 64, HALF = 128, HTB = HALF * BK * 2, STAGE_BYTES = 8 * HTB, NXCD = 8, WGM = 8;
__host__ __device__ __forceinline__ int lds_byte(int r, int c) { const int st = (r >> 4) * 2 + (c >> 5), rr = r & 15, cc = c & 31, ob = rr * 64 + cc * 2; return st * 1024 + (ob ^ (((ob >> 9) & 1) << 5)); }
__host__ __device__ __forceinline__ void stage_rc(int b, int& R, int& C) { const int st = b / 1024, sb = b % 1024, swz = sb ^ (((sb >> 9) & 1) << 5); R = (st >> 1) * 16 + swz / 64; C = (st & 1) * 32 + (swz % 64) / 2; }
__host__ __device__ __forceinline__ int perm32(int rho) { const int n = rho >> 4, i = rho & 15; return 8 * (i >> 2) + 4 * n + (i & 3); }

struct Unit { int pm, pn; };
struct Gemm { const bf16_t* A; const bf16_t* Bt; int M, N, K; };

struct StaticOrder {
    int nM, nN, nwg, G, c;
    __host__ __device__ void init(int M_, int N_, int G_, int c_) { nM = M_ / BM; nN = N_ / BM; nwg = nM * nN; G = G_; c = c_; }
    __host__ __device__ bool next(int i, Unit& u) const {
        const long L = (long)i * G + c; if (L >= nwg) return false;
        int wgid = (int)L; { const int q = nwg / NXCD, r = nwg % NXCD, xcd = wgid % NXCD, off = wgid / NXCD; wgid = (xcd < r ? xcd * (q + 1) : r * (q + 1) + (xcd - r) * q) + off; }
        const int nig = WGM * nN, gid = wgid / nig, fm = gid * WGM, gsz = (nM - fm) < WGM ? (nM - fm) : WGM;
        u.pm = fm + ((wgid % nig) % gsz); u.pn = (wgid % nig) / gsz; return true;
    }
    __device__ __forceinline__ void a_ready(const Unit&) const {}
    __device__ __forceinline__ void done(const Unit&) const {}
};

template <class Epi, class Sched, bool ALIGN_EPI = false, bool SP2 = false>
__device__ __forceinline__ void gemm_phase(PG8_LAS unsigned char* lds, const Gemm g, const Sched& S, const Epi& E) {
    const int tid = threadIdx.x, wid = __builtin_amdgcn_readfirstlane(tid >> 6), lane = tid & 63, wr = wid >> 2, wc = wid & 3, fr = lane & 15, fq = lane >> 4;
    const int K = g.K, nt = K / BK;
    unsigned voffA[2], voffB[2];
#pragma unroll
    for (int i = 0; i < 2; ++i) { int R, C; stage_rc(tid * 16 + i * 8192, R, C); const int Rb = Epi::PERM ? ((R & ~31) + perm32(R & 31)) : R;
        voffA[i] = (unsigned)(R * K + C) * 2u; voffB[i] = (unsigned)(Rb * K + C) * 2u; }
    const size_t kstep = (size_t)(BK * 2);
    const size_t hstep = (size_t)HALF * K * 2;
    const size_t tstep = 2 * hstep;
    const unsigned ldsw = (unsigned)wid * 1024u;
    const int aoff = lds_byte(wr * 64 + fr, fq * 8), boff = lds_byte(wc * 32 + fr, fq * 8);
#define PG8_SA(b, h) (((b) * 2 + (h)) * HTB)
#define PG8_SB(b, h) ((4 + (b) * 2 + (h)) * HTB)
#define PG8_STAGE(bufoff, gbase, voff) do { _Pragma("unroll") for (int _i = 0; _i < 2; ++_i) \
        __builtin_amdgcn_global_load_lds((const unsigned*)((const char*)(gbase) + (voff)[_i]), (PG8_LAS unsigned*)(lds + (bufoff) + ldsw + _i * 8192), 16, 0, 0); } while (0)
#define PG8_LDA(dst, b, h) do { _Pragma("unroll") for (int m = 0; m < 4; ++m) _Pragma("unroll") for (int k = 0; k < 2; ++k) dst[m][k] = *(const PG8_LAS bf16x8*)(lds + PG8_SA(b, h) + aoff + m * 2048 + k * 1024); } while (0)
#define PG8_LDB(dst, b, h) do { _Pragma("unroll") for (int n = 0; n < 2; ++n) _Pragma("unroll") for (int k = 0; k < 2; ++k) dst[n][k] = *(const PG8_LAS bf16x8*)(lds + PG8_SB(b, h) + boff + n * 2048 + k * 1024); } while (0)
#define PG8_MMA(ai, bj, At, Bt) do { __builtin_amdgcn_s_setprio(1); _Pragma("unroll") for (int m = 0; m < 4; ++m) _Pragma("unroll") for (int n = 0; n < 2; ++n) _Pragma("unroll") for (int k = 0; k < 2; ++k) \
        acc[ai][bj][m][n] = __builtin_amdgcn_mfma_f32_16x16x32_bf16(Bt[n][k], At[m][k], acc[ai][bj][m][n], 0, 0, 0); __builtin_amdgcn_s_setprio(0); } while (0)
#define PG8_WAIT_V(n) asm volatile("s_waitcnt vmcnt(" #n ")" ::: "memory")
#define PG8_WAIT_L(n) asm volatile("s_waitcnt lgkmcnt(" #n ")" ::: "memory")
#define PG8_BAR __builtin_amdgcn_s_barrier()
#define PG8_SCHED __builtin_amdgcn_sched_barrier(0)
    Unit cur, nxt; int ui = 0;
    if (!S.next(0, cur)) return;
    f32x4 acc[2][2][4][2];
#pragma unroll
    for (int a = 0; a < 2; ++a)
#pragma unroll
        for (int b = 0; b < 2; ++b)
#pragma unroll
            for (int m = 0; m < 4; ++m)
#pragma unroll
                for (int n = 0; n < 2; ++n) acc[a][b][m][n] = (f32x4){0.f, 0.f, 0.f, 0.f};
    bf16x8 At[4][2], B0[2][2], B1[2][2];
    const char* cA = (const char*)g.A + (size_t)cur.pm * tstep; const char* cB = (const char*)g.Bt + (size_t)cur.pn * tstep;
    S.a_ready(cur);
    if constexpr (SP2) {
        PG8_STAGE(PG8_SB(0, 0), cB, voffB); PG8_STAGE(PG8_SB(0, 1), cB + hstep, voffB); PG8_STAGE(PG8_SA(0, 0), cA, voffA); PG8_STAGE(PG8_SA(0, 1), cA + hstep, voffA);
        if (wr == 1) PG8_BAR;
        PG8_WAIT_V(2); PG8_BAR;
        PG8_STAGE(PG8_SB(1, 0), cB + kstep, voffB); PG8_STAGE(PG8_SA(1, 0), cA + kstep, voffA); PG8_STAGE(PG8_SB(1, 1), cB + hstep + kstep, voffB);
        PG8_WAIT_V(6); PG8_BAR;
    } else {
        PG8_STAGE(PG8_SB(0, 0), cB, voffB); PG8_STAGE(PG8_SA(0, 0), cA, voffA); PG8_STAGE(PG8_SB(0, 1), cB + hstep, voffB); PG8_STAGE(PG8_SA(0, 1), cA + hstep, voffA);
        if (wr == 1) PG8_BAR;
        PG8_WAIT_V(4); PG8_BAR;
        PG8_STAGE(PG8_SB(1, 0), cB + kstep, voffB); PG8_STAGE(PG8_SA(1, 0), cA + kstep, voffA); PG8_STAGE(PG8_SB(1, 1), cB + hstep + kstep, voffB);
        PG8_WAIT_V(6); PG8_BAR;
    }
    for (;;) {
        const bool has_next = S.next(ui + 1, nxt);
        const char* nA = has_next ? (const char*)g.A + (size_t)nxt.pm * tstep : cA; const char* nB = has_next ? (const char*)g.Bt + (size_t)nxt.pn * tstep : cB;
        for (int t = 0; t < nt; t += 2) {
            const bool last = (t == nt - 2);
            const char* a1 = cA + (size_t)(t + 1) * kstep;
            const char* a2 = last ? nA : cA + (size_t)(t + 2) * kstep; const char* b2 = last ? nB : cB + (size_t)(t + 2) * kstep;
            const char* a3 = a2 + kstep; const char* b3 = b2 + kstep;
            if (last && has_next) S.a_ready(nxt);
            if constexpr (SP2) {
            PG8_LDB(B0, 0, 0); PG8_LDB(B1, 0, 1); PG8_SCHED; PG8_LDA(At, 0, 0); PG8_STAGE(PG8_SA(1, 1), a1 + hstep, voffA);
            PG8_WAIT_V(8); PG8_WAIT_L(0); PG8_BAR; PG8_MMA(0, 0, At, B0); PG8_MMA(0, 1, At, B1); PG8_BAR; PG8_SCHED;
            PG8_LDA(At, 0, 1); PG8_STAGE(PG8_SB(0, 0), b2, voffB); PG8_STAGE(PG8_SB(0, 1), b2 + hstep, voffB); PG8_STAGE(PG8_SA(0, 0), a2, voffA);
            PG8_WAIT_V(8); PG8_WAIT_L(0); PG8_BAR; PG8_MMA(1, 0, At, B0); PG8_MMA(1, 1, At, B1); PG8_BAR; PG8_SCHED;
            PG8_LDB(B0, 1, 0); PG8_LDB(B1, 1, 1); PG8_SCHED; PG8_LDA(At, 1, 0); PG8_STAGE(PG8_SA(0, 1), a2 + hstep, voffA);
            PG8_WAIT_V(8); PG8_WAIT_L(0); PG8_BAR; PG8_MMA(0, 0, At, B0); PG8_MMA(0, 1, At, B1); PG8_BAR; PG8_SCHED;
            PG8_LDA(At, 1, 1); PG8_STAGE(PG8_SB(1, 0), b3, voffB); PG8_STAGE(PG8_SB(1, 1), b3 + hstep, voffB); PG8_STAGE(PG8_SA(1, 0), a3, voffA);
            PG8_WAIT_V(8); PG8_WAIT_L(0); PG8_BAR; PG8_MMA(1, 0, At, B0); PG8_MMA(1, 1, At, B1); PG8_BAR; PG8_SCHED;
            } else {
            PG8_LDB(B0, 0, 0); PG8_SCHED; PG8_LDA(At, 0, 0); PG8_STAGE(PG8_SA(1, 1), a1 + hstep, voffA);
            PG8_WAIT_L(8); PG8_BAR; PG8_WAIT_L(0); PG8_MMA(0, 0, At, B0); PG8_BAR; PG8_SCHED;
            PG8_LDB(B1, 0, 1); PG8_STAGE(PG8_SB(0, 0), b2, voffB);
            PG8_BAR; PG8_WAIT_L(0); PG8_MMA(0, 1, At, B1); PG8_BAR;
            PG8_LDA(At, 0, 1); PG8_STAGE(PG8_SA(0, 0), a2, voffA);
            PG8_BAR; PG8_WAIT_L(0); PG8_MMA(1, 0, At, B0); PG8_BAR; PG8_SCHED;
            PG8_STAGE(PG8_SB(0, 1), b2 + hstep, voffB);
            PG8_WAIT_V(6); PG8_BAR; PG8_MMA(1, 1, At, B1); PG8_BAR;
            PG8_LDB(B0, 1, 0); PG8_SCHED; PG8_LDA(At, 1, 0); PG8_STAGE(PG8_SA(0, 1), a2 + hstep, voffA);
            PG8_WAIT_L(8); PG8_BAR; PG8_WAIT_L(0); PG8_MMA(0, 0, At, B0); PG8_BAR; PG8_SCHED;
            PG8_LDB(B1, 1, 1); PG8_STAGE(PG8_SB(1, 0), b3, voffB);
            PG8_BAR; PG8_WAIT_L(0); PG8_MMA(0, 1, At, B1); PG8_BAR;
            PG8_LDA(At, 1, 1); PG8_STAGE(PG8_SA(1, 0), a3, voffA);
            PG8_BAR; PG8_WAIT_L(0); PG8_MMA(1, 0, At, B0); PG8_BAR; PG8_SCHED;
            PG8_STAGE(PG8_SB(1, 1), b3 + hstep, voffB);
            PG8_WAIT_V(6); PG8_BAR; PG8_MMA(1, 1, At, B1); PG8_BAR;
            }
        }
        if constexpr (ALIGN_EPI) { if (wr == 0) PG8_BAR; }
        E(acc, cur, wr, wc, fr, fq); S.done(cur);
        if (!has_next) break;
#pragma unroll
        for (int a = 0; a < 2; ++a)
#pragma unroll
            for (int b = 0; b < 2; ++b)
#pragma unroll
                for (int m = 0; m < 4; ++m)
#pragma unroll
                    for (int n = 0; n < 2; ++n) acc[a][b][m][n] = (f32x4){0.f, 0.f, 0.f, 0.f};
        cur = nxt; cA = nA; cB = nB; ++ui;
        if constexpr (ALIGN_EPI) { if (wr == 1) PG8_BAR; }
    }
    PG8_WAIT_V(0);
    if constexpr (!ALIGN_EPI) { if (wr == 0) PG8_BAR; }
    PG8_BAR;
#undef PG8_SA
#undef PG8_SB
#undef PG8_STAGE
#undef PG8_LDA
#undef PG8_LDB
#undef PG8_MMA
#undef PG8_WAIT_V
#undef PG8_WAIT_L
#undef PG8_BAR
#undef PG8_SCHED
}

__device__ __forceinline__ float row_rstd(const float* SS, int row) {
    const f32x4* p = (const f32x4*)(SS + (size_t)row * 16);
    const f32x4 a = p[0], b = p[1], c = p[2], d = p[3];
    const float s = (((a.x + a.y) + (a.z + a.w)) + ((b.x + b.y) + (b.z + b.w))) + (((c.x + c.y) + (c.z + c.w)) + ((d.x + d.y) + (d.z + d.w)));
    return frsq(s * (1.0f / 1024.0f) + EPS);
}
__device__ __forceinline__ u32x4 pack8(const f32x4 v0, const f32x4 v1) { u32x4 w; w.x = cvt_pk_bf16(v0[0], v0[1]); w.y = cvt_pk_bf16(v0[2], v0[3]); w.z = cvt_pk_bf16(v1[0], v1[1]); w.w = cvt_pk_bf16(v1[2], v1[3]); return w; }

struct EpiInProj {
    static constexpr bool PERM = true;
    const float* SS; const float* LB; bf16_t* QVS; unsigned short* LOGF;
    __device__ __forceinline__ void operator()(const f32x4 (&acc)[2][2][4][2], const Unit& u, int wr, int wc, int fr, int fq) const {
        const int row0 = u.pm * BM + wr * 64 + fr;
        const int typ = u.pn >> 2;
        const int col0 = (u.pn & 3) * 256 + wc * 32 + 8 * fq;
        float rs[2][4];
#pragma unroll
        for (int ai = 0; ai < 2; ++ai)
#pragma unroll
            for (int m = 0; m < 4; ++m) rs[ai][m] = row_rstd(SS, row0 + ai * HALF + m * 16);
        if (typ == 1) {
            f32x4 lb[2][2];
#pragma unroll
            for (int bj = 0; bj < 2; ++bj)
#pragma unroll
                for (int n = 0; n < 2; ++n) lb[bj][n] = *(const f32x4*)(LB + col0 + bj * HALF + 4 * n);
#pragma unroll
            for (int ai = 0; ai < 2; ++ai)
#pragma unroll
                for (int m = 0; m < 4; ++m) { unsigned short* rowp = LOGF + (size_t)(row0 + ai * HALF + m * 16) * D + col0; const float r = rs[ai][m];
#pragma unroll
                    for (int bj = 0; bj < 2; ++bj) { f32x4 o[2];
#pragma unroll
                        for (int n = 0; n < 2; ++n)
#pragma unroll
                            for (int j = 0; j < 4; ++j) { const float x = acc[ai][bj][m][n][j] * r; const float sg = frcp(1.0f + fexp(-x)); const float l = lb[bj][n][j]; o[n][j] = __builtin_amdgcn_logf(l + (1.0f - l) * sg); }
                        u32x4 w; w.x = pk_f16(o[0][0], o[0][1]); w.y = pk_f16(o[0][2], o[0][3]); w.z = pk_f16(o[1][0], o[1][1]); w.w = pk_f16(o[1][2], o[1][3]);
                        *(u32x4*)(rowp + bj * HALF) = w; } }
        } else {
            bf16_t* base = QVS + (size_t)(typ - (typ > 0 ? 1 : 0)) * ((size_t)M * D);
#pragma unroll
            for (int ai = 0; ai < 2; ++ai)
#pragma unroll
                for (int m = 0; m < 4; ++m) { bf16_t* rowp = base + (size_t)(row0 + ai * HALF + m * 16) * D + col0; const float r = rs[ai][m];
#pragma unroll
                    for (int bj = 0; bj < 2; ++bj) { f32x4 v0 = acc[ai][bj][m][0] * r, v1 = acc[ai][bj][m][1] * r;
                        if (typ == 3) {
#pragma unroll
                            for (int j = 0; j < 4; ++j) { v0[j] = v0[j] * frcp(1.0f + fexp(-v0[j])); v1[j] = v1[j] * frcp(1.0f + fexp(-v1[j])); } }
                        *(u32x4*)(rowp + bj * HALF) = pack8(v0, v1); } }
        }
    }
};
struct EpiUp {
    static constexpr bool PERM = true;
    const float* SS; bf16_t* HID;
    __device__ __forceinline__ void operator()(const f32x4 (&acc)[2][2][4][2], const Unit& u, int wr, int wc, int fr, int fq) const {
        const int row0 = u.pm * BM + wr * 64 + fr, col0 = u.pn * BM + wc * 32 + 8 * fq;
#pragma unroll
        for (int ai = 0; ai < 2; ++ai)
#pragma unroll
            for (int m = 0; m < 4; ++m) { const int row = row0 + ai * HALF + m * 16; const float r = row_rstd(SS, row); bf16_t* rowp = HID + (size_t)row * FF + col0;
#pragma unroll
                for (int bj = 0; bj < 2; ++bj) { f32x4 v0 = acc[ai][bj][m][0] * r, v1 = acc[ai][bj][m][1] * r;
#pragma unroll
                    for (int j = 0; j < 4; ++j) { const float a = fmaxf(v0[j], 0.f), b = fmaxf(v1[j], 0.f); v0[j] = a * a; v1[j] = b * b; }
                    *(u32x4*)(rowp + bj * HALF) = pack8(v0, v1); } }
    }
};
template <bool RES_BF16, bool WRITE_X, bool WRITE_H>
struct EpiRes {
    static constexpr bool PERM = true;
    const float* ra; const float* rb; const bf16_t* XR; float* H; bf16_t* XO; float* SS;
    __device__ __forceinline__ void operator()(const f32x4 (&acc)[2][2][4][2], const Unit& u, int wr, int wc, int fr, int fq) const {
        const int row0 = u.pm * BM + wr * 64 + fr, col0 = u.pn * BM + wc * 32 + 8 * fq;
#pragma unroll
        for (int ai = 0; ai < 2; ++ai)
#pragma unroll
            for (int m = 0; m < 4; ++m) { const int row = row0 + ai * HALF + m * 16;
                float ssq = 0.f;
#pragma unroll
                for (int bj = 0; bj < 2; ++bj) { f32x4 r0, r1;
                    if (RES_BF16) { const u32x4 w = *(const u32x4*)(XR + (size_t)row * D + col0 + bj * HALF); r0 = (f32x4){bf_lo(w.x), bf_hi(w.x), bf_lo(w.y), bf_hi(w.y)}; r1 = (f32x4){bf_lo(w.z), bf_hi(w.z), bf_lo(w.w), bf_hi(w.w)}; }
                    else { const float* rp = (row < MP ? ra + (size_t)row * D : rb + (size_t)(row - MP) * D) + col0 + bj * HALF; r0 = *(const f32x4*)rp; r1 = *(const f32x4*)(rp + 4); }
                    const f32x4 v0 = r0 + acc[ai][bj][m][0], v1 = r1 + acc[ai][bj][m][1];
                    ssq += ((v0[0] * v0[0] + v0[1] * v0[1]) + (v0[2] * v0[2] + v0[3] * v0[3])) + ((v1[0] * v1[0] + v1[1] * v1[1]) + (v1[2] * v1[2] + v1[3] * v1[3]));
                    if (WRITE_H) { float* hp = H + (size_t)row * D + col0 + bj * HALF; *(f32x4*)hp = v0; *(f32x4*)(hp + 4) = v1; }
                    if (WRITE_X) *(u32x4*)(XO + (size_t)row * D + col0 + bj * HALF) = pack8(v0, v1); }
                ssq += __shfl_xor(ssq, 16); ssq += __shfl_xor(ssq, 32);
                if (fq == 0) SS[(size_t)row * 16 + u.pn * 4 + wc] = ssq;
                asm volatile("" ::: "memory"); }
    }
};
struct EpiConvIn {
    static constexpr bool PERM = true;
    const float* SS; bf16_t* BG; bf16_t* Z; float* scp; float* scs;
    __device__ __forceinline__ void operator()(const f32x4 (&acc)[2][2][4][2], const Unit& u, int wr, int wc, int fr, int fq) const {
        const int row0 = u.pm * BM + wr * 64 + fr;
#pragma unroll
        for (int ai = 0; ai < 2; ++ai)
#pragma unroll
            for (int m = 0; m < 4; ++m) { const int row = row0 + ai * HALF + m * 16; const float r = row_rstd(SS, row);
                if (u.pn < 4) { bf16_t* rowp = BG + (size_t)row * D + u.pn * BM + wc * 32 + 8 * fq;
#pragma unroll
                    for (int bj = 0; bj < 2; ++bj) *(u32x4*)(rowp + bj * HALF) = pack8(acc[ai][bj][m][0] * r, acc[ai][bj][m][1] * r);
                } else { const int col = (u.pn - 4) * 128 + wc * 32 + 8 * fq; const float r2 = r * r;
                    const f32x4 z0 = acc[ai][0][m][0] * acc[ai][1][m][0] * r2, z1 = acc[ai][0][m][1] * acc[ai][1][m][1] * r2;
                    *(u32x4*)(Z + (size_t)row * D + col) = pack8(z0, z1);
                    float* sp = nullptr;
                    if (row < MP) { const int t = row & (TP - 1); if (t >= TP - 2) sp = scp + ((size_t)(row >> 12) * 2 + (t - (TP - 2))) * D + col; }
                    else { const int r2i = row - MP, t = r2i & (TS - 1); if (t >= TS - 2) sp = scs + ((size_t)(r2i >> 5) * 2 + (t - (TS - 2))) * D + col; }
                    if (sp) { *(f32x4*)sp = z0; *(f32x4*)(sp + 4) = z1; } } }
    }
};
}

#define XB_TMO      128
#define XB_XCNT(j)  (256  + 64 * (j))
#define XB_XSUB(j)  (1280 + 64 * (j))
#define XB_XGEN(j)  (2304 + 64 * (j))
#define XB_TOP      3328
#define XB_TOPGEN   3392
#define XCD_BAR_WORDS 3456
#define XB_SPIN_CAP (1u << 18)
__device__ __forceinline__ unsigned xb_ld(unsigned* p)              { return __hip_atomic_load(p, __ATOMIC_RELAXED, __HIP_MEMORY_SCOPE_AGENT); }
__device__ __forceinline__ unsigned xb_add(unsigned* p, unsigned v) { return __hip_atomic_fetch_add(p, v, __ATOMIC_RELAXED, __HIP_MEMORY_SCOPE_AGENT); }
__device__ __forceinline__ unsigned xb_xcc_id() { return (unsigned)__builtin_amdgcn_s_getreg((3 << 11) | 20) & 0xFu; }
#define XB_SPIN(cond, bar) do { unsigned _sp = 0; while (cond) { __builtin_amdgcn_s_sleep(1); \
    if ((++_sp & 255u) == 0u) { if (xb_ld(&(bar)[XB_TMO])) break; if (_sp > XB_SPIN_CAP) { atomicAdd(&(bar)[XB_TMO], 1u); break; } } } } while (0)
struct XcdBarrier { unsigned* bar; unsigned x; volatile LAS unsigned* st; };
__device__ __forceinline__ XcdBarrier xcd_barrier_post(unsigned* bar, volatile LAS unsigned* st) {
    XcdBarrier b; b.bar = bar; b.x = xb_xcc_id(); b.st = st;
    if (threadIdx.x == 0) (void)xb_add(&bar[XB_XCNT(b.x)], 1u);
    return b;
}
__device__ __forceinline__ void xcd_barrier_complete(unsigned* bar, unsigned x, unsigned& nloc, unsigned& nx) {
    const unsigned G = gridDim.x * gridDim.y * gridDim.z;
    unsigned sum, cnt, mine, sp = 0u;
    for (;;) {
        sum = 0u; cnt = 0u; mine = 0u;
#pragma unroll
        for (unsigned j = 0; j < 16; ++j) { const unsigned c = xb_ld(&bar[XB_XCNT(j)]); sum += c; cnt += (c > 0u) ? 1u : 0u; mine = (j == x) ? c : mine; }
        if (sum == G) break;
        __builtin_amdgcn_s_sleep(1);
        if ((++sp & 255u) == 0u) { if (xb_ld(&bar[XB_TMO])) break; if (sp > XB_SPIN_CAP) { atomicAdd(&bar[XB_TMO], 1u); break; } }
    }
    nloc = mine > 0u ? mine : 1u; nx = cnt > 0u ? cnt : 1u;
}
__device__ __forceinline__ void xcd_barrier(const XcdBarrier& b) {
    asm volatile("s_waitcnt vmcnt(0)" ::: "memory");
    __syncthreads();
    if (threadIdx.x == 0) {
        unsigned* bar = b.bar;
        __builtin_amdgcn_s_waitcnt(0);
        unsigned nloc = b.st[0], nx = b.st[1];
        if (nloc == 0u) { xcd_barrier_complete(bar, b.x, nloc, nx); b.st[0] = nloc; b.st[1] = nx; }
        const unsigned old = xb_add(&bar[XB_XSUB(b.x)], 1u);
        const unsigned gen = old / nloc;
        if (old + 1u == (gen + 1u) * nloc) {
            __builtin_amdgcn_fence(__ATOMIC_RELEASE, "agent");
            asm volatile("s_waitcnt vmcnt(0)" ::: "memory");
            const unsigned og = xb_add(&bar[XB_TOP], 1u);
            const unsigned tg = og / nx;
            if (og + 1u == (tg + 1u) * nx) xb_add(&bar[XB_TOPGEN], 1u);
            else XB_SPIN(xb_ld(&bar[XB_TOPGEN]) == tg, bar);
            __builtin_amdgcn_fence(__ATOMIC_ACQUIRE, "agent");
            xb_add(&bar[XB_XGEN(b.x)], 1u);
            asm volatile("s_waitcnt vmcnt(0)" ::: "memory");
        } else {
            XB_SPIN(xb_ld(&bar[XB_XGEN(b.x)]) == gen, bar);
            __builtin_amdgcn_fence(__ATOMIC_ACQUIRE, "agent");
            asm volatile("s_waitcnt vmcnt(0)" ::: "memory");
        }
    }
    __syncthreads();
}

__device__ __forceinline__ float wave_sum(float v) {
#pragma unroll
    for (int o = 1; o < 64; o <<= 1) v += __shfl_xor(v, o);
    return v;
}
__device__ __forceinline__ void p0_transpose_item(const float* W, int K, int Nsrc, int src_n0, const float* gain, bf16_t* WT, int dst_n0, int k0, LAS float* scr, int lane) {
#pragma unroll 8
    for (int i = 0; i < 32; ++i) { const int kk = 2 * i + (lane >> 5); const float gv = gain ? gain[k0 + kk] : 1.0f; scr[kk * 33 + (lane & 31)] = W[(size_t)(k0 + kk) * Nsrc + src_n0 + (lane & 31)] * gv; }
    LDS_WAIT(); asm volatile("" ::: "memory");
    const int c = lane & 7;
#pragma unroll
    for (int j = 0; j < 4; ++j) { const int n = (lane >> 3) + 8 * j; const LAS float* s = scr + (8 * c) * 33 + n;
        u32x4 o; o.x = cvt_pk_bf16(s[0 * 33], s[1 * 33]); o.y = cvt_pk_bf16(s[2 * 33], s[3 * 33]); o.z = cvt_pk_bf16(s[4 * 33], s[5 * 33]); o.w = cvt_pk_bf16(s[6 * 33], s[7 * 33]);
        *(u32x4*)(WT + (size_t)(dst_n0 + n) * K + k0 + 8 * c) = o; }
    LDS_WAIT(); asm volatile("" ::: "memory");
}
template <bool CONVMAP>
__device__ __forceinline__ void p0_matrix(const float* W, int K, int N, const float* gain, bf16_t* WT, LAS float* scr, int gw, int NGW, int lane, int& base) {
    const int nblk = N / 32, nitems = (K / 64) * nblk;
    for (int it = (gw + NGW - (base % NGW)) % NGW; it < nitems; it += NGW) {
        const int kb = it / nblk, nb = it % nblk, dn0 = 32 * nb; int sn0 = dn0;
        if (CONVMAP && dn0 >= 1024) { const int i = (dn0 >> 8) - 4, cc = dn0 & 255; sn0 = 1024 + (cc >> 7) * 1024 + 128 * i + (cc & 127); }
        p0_transpose_item(W, K, N, sn0, gain, WT, dn0, 64 * kb, scr, lane);
    }
    base += nitems;
}

#ifdef PROBE_ID
#define PT0(id) do { if ((id) == PROBE_ID) { __builtin_amdgcn_sched_barrier(0); pt0 = __builtin_amdgcn_s_memtime(); __builtin_amdgcn_sched_barrier(0); } } while (0)
#define PT1(id) do { if ((id) == PROBE_ID) { __builtin_amdgcn_sched_barrier(0); pacc += __builtin_amdgcn_s_memtime() - pt0; __builtin_amdgcn_sched_barrier(0); } } while (0)
#else
#define PT0(id) do { } while (0)
#define PT1(id) do { } while (0)
#endif
constexpr int R_QT = 0, R_KT = 17408, R_KH = 34816, R_VT = 53248, R_AM = 71680, R_GS = 80896, R_SEG = 98304, R_DD = 102400, R_SSQ = 102912;
constexpr int QS = 136, KS = 72;
#define MFMA16(a, b, c) __builtin_amdgcn_mfma_f32_16x16x32_bf16((a), (b), (c), 0, 0, 0)

template <bool OUT>
__device__ __forceinline__ void recur_item(LAS unsigned char* lds, const int tid, const int wid, const int lane,
                                           const bf16_t* __restrict__ Qg, const unsigned short* __restrict__ Lg, const bf16_t* __restrict__ Vg, const bf16_t* __restrict__ SGg,
                                           const int row0, const int ntok, const int nchunk, const int hd,
                                           const float* S_in, float* S_out, float* dec_out, bf16_t* XO, unsigned long long& pt0, unsigned long long& pacc) {
    const int fr = lane & 15, fq = lane >> 4, seg = wid, cp = lane;
    LAS bf16_t* QT = (LAS bf16_t*)(lds + R_QT); LAS bf16_t* KT = (LAS bf16_t*)(lds + R_KT); LAS bf16_t* KH = (LAS bf16_t*)(lds + R_KH);
    LAS bf16_t* VT = (LAS bf16_t*)(lds + R_VT); LAS bf16_t* AM = (LAS bf16_t*)(lds + R_AM); LAS unsigned short* GS = (LAS unsigned short*)(lds + R_GS);
    LAS float* SEG = (LAS float*)(lds + R_SEG); LAS float* DD = (LAS float*)(lds + R_DD); LAS float* SSQ = (LAS float*)(lds + R_SSQ);
    u32x4 gst[2], vst[2], qst[2];
    const size_t cbase = (size_t)hd * HD;
#define RC_ISSUE(cc) do { const int tb_ = 64 * (cc); \
        _Pragma("unroll") for (int k = 0; k < 2; ++k) { int t_ = tb_ + (tid >> 4) + 32 * k; t_ = t_ < ntok ? t_ : ntok - 1; const size_t ix_ = (size_t)(row0 + t_) * D + cbase + 8 * (tid & 15); \
            gst[k] = *(const u32x4*)(Lg + ix_); vst[k] = *(const u32x4*)(Vg + ix_); if (OUT) qst[k] = *(const u32x4*)(Qg + ix_); } } while (0)
    RC_ISSUE(0);
    f32x4 S[8];
#pragma unroll
    for (int i = 0; i < 8; ++i)
#pragma unroll
        for (int j = 0; j < 4; ++j) S[i][j] = S_in ? S_in[(size_t)(16 * i + 4 * fq + j) * HD + 16 * wid + fr] : 0.f;
    f32x2 dlog = (f32x2){0.f, 0.f};
    for (int c = 0; c < nchunk; ++c) {
        const int tok0 = 64 * c;
        if (OUT) PT0(1);
#pragma unroll
        for (int k = 0; k < 2; ++k) { *(LAS u32x4*)(GS + ((tid >> 4) + 32 * k) * QS + 8 * (tid & 15)) = gst[k]; *(LAS u32x4*)(KT + ((tid >> 4) + 32 * k) * QS + 8 * (tid & 15)) = vst[k]; if (OUT) *(LAS u32x4*)(QT + ((tid >> 4) + 32 * k) * QS + 8 * (tid & 15)) = qst[k]; }
        if (c + 1 < nchunk) RC_ISSUE(c + 1);
        u32x2 sgp[4];
        if (OUT) {
#pragma unroll
            for (int tt = 0; tt < 4; ++tt) { int t_ = tok0 + 16 * tt + fr; t_ = t_ < ntok ? t_ : ntok - 1; sgp[tt] = *(const u32x2*)(SGg + (size_t)(row0 + t_) * D + cbase + 16 * wid + 4 * fq); }
        }
        __syncthreads();
        f32x2 g[8], cs[8];
#pragma unroll
        for (int i = 0; i < 8; ++i) { const bool ok = tok0 + 8 * seg + i < ntok; const unsigned w = *(const LAS unsigned*)(GS + (8 * seg + i) * QS + 2 * cp); g[i].x = ok ? h_lo(w) : 0.f; g[i].y = ok ? h_hi(w) : 0.f; }
        cs[0] = g[0];
#pragma unroll
        for (int i = 1; i < 8; ++i) cs[i] = cs[i - 1] + g[i];
        *(LAS f32x2*)(SEG + seg * 128 + 2 * cp) = cs[7];
        __syncthreads();
        f32x2 off = (f32x2){0.f, 0.f}, tot = (f32x2){0.f, 0.f};
#pragma unroll
        for (int s2 = 0; s2 < 8; ++s2) { const f32x2 v = *(const LAS f32x2*)(SEG + s2 * 128 + 2 * cp); tot = tot + v; if (s2 < seg) off = off + v; }
        const float dt0 = __builtin_amdgcn_exp2f(tot.x), dt1 = __builtin_amdgcn_exp2f(tot.y);
        if (seg == 0) { *(LAS f32x2*)(DD + 2 * cp) = (f32x2){dt0, dt1}; dlog = dlog + tot; }
        float kh0[8], kh1[8]; unsigned vv[8];
#pragma unroll
        for (int i = 0; i < 8; ++i) { const int tl = 8 * seg + i; const bool ok = tok0 + tl < ntok;
            unsigned vraw = *(const LAS unsigned*)(KT + tl * QS + 2 * cp); vv[i] = ok ? vraw : 0u;
            const float b0 = off.x + cs[i].x, b1 = off.y + cs[i].y; const float e0 = __builtin_amdgcn_exp2f(b0), e1 = __builtin_amdgcn_exp2f(b1), ie0 = frcp(e0), ie1 = frcp(e1);
            const float kt0 = (1.0f - __builtin_amdgcn_exp2f(g[i].x)) * ie0, kt1 = (1.0f - __builtin_amdgcn_exp2f(g[i].y)) * ie1;
            if (OUT) { unsigned qraw = *(const LAS unsigned*)(QT + tl * QS + 2 * cp); qraw = ok ? qraw : 0u;
                *(LAS unsigned*)(QT + tl * QS + 2 * cp) = cvt_pk_bf16(bf_lo(qraw) * e0, bf_hi(qraw) * e1);
                *(LAS unsigned*)(KT + tl * QS + 2 * cp) = cvt_pk_bf16(kt0, kt1); }
            kh0[i] = kt0 * dt0; kh1[i] = kt1 * dt1; }
        { u32x4 w0, w1;
          w0.x = cvt_pk_bf16(kh0[0], kh0[1]); w0.y = cvt_pk_bf16(kh0[2], kh0[3]); w0.z = cvt_pk_bf16(kh0[4], kh0[5]); w0.w = cvt_pk_bf16(kh0[6], kh0[7]);
          w1.x = cvt_pk_bf16(kh1[0], kh1[1]); w1.y = cvt_pk_bf16(kh1[2], kh1[3]); w1.z = cvt_pk_bf16(kh1[4], kh1[5]); w1.w = cvt_pk_bf16(kh1[6], kh1[7]);
          *(LAS u32x4*)(KH + (2 * cp) * KS + 8 * seg) = w0; *(LAS u32x4*)(KH + (2 * cp + 1) * KS + 8 * seg) = w1;
          u32x4 x0, x1;
          x0.x = (vv[0] & 0xffffu) | (vv[1] << 16); x0.y = (vv[2] & 0xffffu) | (vv[3] << 16); x0.z = (vv[4] & 0xffffu) | (vv[5] << 16); x0.w = (vv[6] & 0xffffu) | (vv[7] << 16);
          x1.x = (vv[0] >> 16) | (vv[1] & 0xffff0000u); x1.y = (vv[2] >> 16) | (vv[3] & 0xffff0000u); x1.z = (vv[4] >> 16) | (vv[5] & 0xffff0000u); x1.w = (vv[6] >> 16) | (vv[7] & 0xffff0000u);
          *(LAS u32x4*)(VT + (2 * cp) * KS + 8 * seg) = x0; *(LAS u32x4*)(VT + (2 * cp + 1) * KS + 8 * seg) = x1; }
        __syncthreads();
        if (OUT) { PT1(1); PT0(2); }
        if (OUT) {
            const int tt = wid >> 1;
#pragma unroll
            for (int h2 = 0; h2 < 2; ++h2) { const int st = 2 * (wid & 1) + h2; f32x4 a = (f32x4){0.f, 0.f, 0.f, 0.f};
#pragma unroll
                for (int ks = 0; ks < 4; ++ks) { const bf16x8 kf = *(const LAS bf16x8*)(KT + (16 * st + fr) * QS + 32 * ks + 8 * fq); const bf16x8 qf = *(const LAS bf16x8*)(QT + (16 * tt + fr) * QS + 32 * ks + 8 * fq);
                    a = MFMA16(kf, qf, a); }
                const int t = 16 * tt + fr;
#pragma unroll
                for (int j = 0; j < 4; ++j) a[j] = (16 * st + 4 * fq + j <= t) ? a[j] : 0.f;
                u32x2 w; w.x = cvt_pk_bf16(a[0], a[1]); w.y = cvt_pk_bf16(a[2], a[3]);
                *(LAS u32x2*)(AM + t * KS + 16 * st + 4 * fq) = w; }
            __syncthreads();
        }
        if (OUT) { PT1(2); PT0(3); }
        bf16x8 vf[2];
#pragma unroll
        for (int ks = 0; ks < 2; ++ks) vf[ks] = *(const LAS bf16x8*)(VT + (16 * wid + fr) * KS + 32 * ks + 8 * fq);
        f32x4 o[4];
        if (OUT) {
            bf16x8 Sb[4];
#pragma unroll
            for (int ks = 0; ks < 4; ++ks) { u32x4 w; w.x = cvt_pk_bf16(S[2 * ks][0], S[2 * ks][1]); w.y = cvt_pk_bf16(S[2 * ks][2], S[2 * ks][3]); w.z = cvt_pk_bf16(S[2 * ks + 1][0], S[2 * ks + 1][1]); w.w = cvt_pk_bf16(S[2 * ks + 1][2], S[2 * ks + 1][3]);
                Sb[ks] = __builtin_bit_cast(bf16x8, w); }
#pragma unroll
            for (int tt = 0; tt < 4; ++tt) { o[tt] = (f32x4){0.f, 0.f, 0.f, 0.f};
#pragma unroll
                for (int ks = 0; ks < 4; ++ks) { const u32x2 lo = *(const LAS u32x2*)(QT + (16 * tt + fr) * QS + 32 * ks + 4 * fq), hi = *(const LAS u32x2*)(QT + (16 * tt + fr) * QS + 32 * ks + 16 + 4 * fq);
                    u32x4 w; w.x = lo.x; w.y = lo.y; w.z = hi.x; w.w = hi.y;
                    o[tt] = MFMA16(Sb[ks], __builtin_bit_cast(bf16x8, w), o[tt]); }
#pragma unroll
                for (int ks = 0; ks < 2; ++ks) { const bf16x8 af = *(const LAS bf16x8*)(AM + (16 * tt + fr) * KS + 32 * ks + 8 * fq); o[tt] = MFMA16(vf[ks], af, o[tt]); } }
        }
#pragma unroll
        for (int i = 0; i < 8; ++i) { const f32x4 dv = *(const LAS f32x4*)(DD + 16 * i + 4 * fq); S[i] = S[i] * dv;
#pragma unroll
            for (int ks = 0; ks < 2; ++ks) { const bf16x8 kf = *(const LAS bf16x8*)(KH + (16 * i + fr) * KS + 32 * ks + 8 * fq); S[i] = MFMA16(kf, vf[ks], S[i]); } }
        if (OUT) {
#pragma unroll
            for (int tt = 0; tt < 4; ++tt) { float p = (o[tt][0] * o[tt][0] + o[tt][1] * o[tt][1]) + (o[tt][2] * o[tt][2] + o[tt][3] * o[tt][3]);
                p += __shfl_xor(p, 16); p += __shfl_xor(p, 32);
                if (fq == 0) SSQ[(16 * tt + fr) * 8 + wid] = p; }
            __syncthreads();
            PT1(3); PT0(4);
#pragma unroll
            for (int tt = 0; tt < 4; ++tt) { const int t = 16 * tt + fr; const f32x4 a = *(const LAS f32x4*)(SSQ + t * 8), b = *(const LAS f32x4*)(SSQ + t * 8 + 4);
                const float tot2 = ((a.x + a.y) + (a.z + a.w)) + ((b.x + b.y) + (b.z + b.w)); const float r = frsq(tot2 * (1.0f / HD) + EPS);
                const int tk = tok0 + t;
                if (tk < ntok) { const size_t idx = (size_t)(row0 + tk) * D + cbase + 16 * wid + 4 * fq; const u32x2 sg = sgp[tt];
                    u32x2 w; w.x = cvt_pk_bf16(o[tt][0] * r * bf_lo(sg.x), o[tt][1] * r * bf_hi(sg.x)); w.y = cvt_pk_bf16(o[tt][2] * r * bf_lo(sg.y), o[tt][3] * r * bf_hi(sg.y));
                    *(u32x2*)(XO + idx) = w; } }
            PT1(4);
        } else {
            __syncthreads();
        }
    }
#undef RC_ISSUE
    if (S_out) {
#pragma unroll
        for (int i = 0; i < 8; ++i)
#pragma unroll
            for (int j = 0; j < 4; ++j) S_out[(size_t)(16 * i + 4 * fq + j) * HD + 16 * wid + fr] = S[i][j];
    }
    if (dec_out && seg == 0) *(f32x2*)(dec_out + 2 * cp) = (f32x2){__builtin_amdgcn_exp2f(dlog.x), __builtin_amdgcn_exp2f(dlog.y)};
    __syncthreads();
}

struct Args { const float* in[16]; float* outp; unsigned char* wsp; int ph_lo, ph_hi; };
constexpr int N_PHASES = 14;

constexpr size_t O_Y = 0, O_SHP = (size_t)M * D, O_SCP = O_SHP + (size_t)NBP * NH * HD * HD, O_SHS = O_SCP + (size_t)NBP * 2 * D, O_SCS = O_SHS + (size_t)NBS * NH * HD * HD, O_END = O_SCS + (size_t)NBS * 2 * D;

__global__ void __launch_bounds__(512, 2) mk_fwd(Args args) {
    extern __shared__ __attribute__((aligned(16))) unsigned char lds_raw[];
    LAS unsigned char* lds = (LAS unsigned char*)lds_raw;
    volatile LAS unsigned* MISC = (volatile LAS unsigned*)(lds + MISC_OFF);
    const int tid = threadIdx.x, lane = tid & 63, wave = __builtin_amdgcn_readfirstlane(tid >> 6);
    const int G = gridDim.x;
    const int vcu = (G % 8 == 0) ? ((int)blockIdx.x % 8) * (G / 8) + (int)blockIdx.x / 8 : (int)blockIdx.x;
    const int gw = vcu * 8 + wave, NGW = G * 8;
#define ctl ((unsigned*)(args.wsp + WS_CTL))
#define x_prompt (args.in[0])
#define x_sample (args.in[1])
#define state_hgrn (args.in[2])
#define state_conv (args.in[3])
#define norm_mix (args.in[4])
#define norm_mlp (args.in[5])
#define norm_final (args.in[6])
#define w_in_hgrn (args.in[7])
#define lb_hgrn (args.in[8])
#define g_norm_hgrn (args.in[9])
#define w_out_hgrn (args.in[10])
#define w_in_conv (args.in[11])
#define conv_w (args.in[12])
#define w_out_conv (args.in[13])
#define w_up (args.in[14])
#define w_down (args.in[15])
#define out (args.outp)
#define H (args.outp + O_Y)
#define LB ((float*)(args.wsp + WS_LB))
#define SS ((float*)(args.wsp + WS_SS))
#define DEC ((float*)(args.wsp + WS_DEC))
#define W1 ((bf16_t*)(args.wsp + WS_W1))
#define W2 ((bf16_t*)(args.wsp + WS_W2))
#define W3 ((bf16_t*)(args.wsp + WS_W3))
#define W4 ((bf16_t*)(args.wsp + WS_W4))
#define W5 ((bf16_t*)(args.wsp + WS_W5))
#define W6 ((bf16_t*)(args.wsp + WS_W6))
#define W7 ((bf16_t*)(args.wsp + WS_W7))
#define W8 ((bf16_t*)(args.wsp + WS_W8))
#define XA ((bf16_t*)(args.wsp + WS_XA))
#define XB ((bf16_t*)(args.wsp + WS_XB))
#define LOCAL ((float*)(args.wsp + WS_LOCAL))
#define Qb ((bf16_t*)(args.wsp + WS_Q))
#define Vb ((bf16_t*)(args.wsp + WS_V))
#define SGb ((bf16_t*)(args.wsp + WS_SG))
#define LOGF ((unsigned short*)(args.wsp + WS_LOGF))
#define HID ((bf16_t*)(args.wsp + WS_HID))
#define BG ((bf16_t*)(args.wsp + WS_BG))
#define Zb ((bf16_t*)(args.wsp + WS_Z))
    for (int u = tid; u < (LDS_BYTES - LDSCTL_OFF) / 4; u += 512) ((LAS unsigned*)(lds + LDSCTL_OFF))[u] = 0u;
    __syncthreads();
    XcdBarrier bar = xcd_barrier_post(ctl + CW_BAR, MISC + 8);
    const int lo = args.ph_lo, hi = args.ph_hi;
    unsigned long long pt0 = 0, pacc = 0;
#define IN(k) (lo <= (k) && (k) < hi)
#define SEAM(k) do { if (IN(k) && IN((k) + 1)) xcd_barrier(bar); } while (0)
#ifndef DUP_PHASE
#define DUP_PHASE -1
#endif
#define PH_BEGIN(k) if (IN(k)) { PT0(100 + (k)); for (int rep_ = 0; rep_ < ((k) == DUP_PHASE ? 2 : 1); ++rep_) { if (rep_) xcd_barrier(bar);
#define PH_END(k) } PT1(100 + (k)); }

    PH_BEGIN(0)
        LAS float* scr = (LAS float*)(lds + wave * 16384);
        int base = 0;
        p0_matrix<false>(w_in_hgrn, D, 4 * D, norm_mix, W1, scr, gw, NGW, lane, base);
        p0_matrix<false>(w_out_hgrn, D, D, g_norm_hgrn, W2, scr, gw, NGW, lane, base);
        p0_matrix<false>(w_up, D, FF, norm_mlp, W3, scr, gw, NGW, lane, base);
        p0_matrix<false>(w_down, FF, D, nullptr, W4, scr, gw, NGW, lane, base);
        p0_matrix<true>(w_in_conv, D, 3 * D, norm_mix + D, W5, scr, gw, NGW, lane, base);
        p0_matrix<false>(w_out_conv, D, D, nullptr, W6, scr, gw, NGW, lane, base);
        p0_matrix<false>(w_up + (size_t)D * FF, D, FF, norm_mlp + D, W7, scr, gw, NGW, lane, base);
        p0_matrix<false>(w_down + (size_t)FF * D, FF, D, nullptr, W8, scr, gw, NGW, lane, base);
        if (blockIdx.x == 0) { for (int c = tid; c < D; c += 512) { const float l0 = lb_hgrn[c], l1 = lb_hgrn[D + c]; const float mx = fmaxf(l0, l1); const float e0 = expf(l0 - mx), e1 = expf(l1 - mx); LB[c] = e0 / (e0 + e1); } }
        for (int row = gw; row < M; row += NGW) {
            const float* xr = row < MP ? x_prompt + (size_t)row * D : x_sample + (size_t)(row - MP) * D;
            const f32x4* xp = (const f32x4*)xr + lane; f32x4 v[4]; float s = 0.f;
#pragma unroll
            for (int j = 0; j < 4; ++j) { v[j] = xp[64 * j]; s += (v[j].x * v[j].x + v[j].y * v[j].y) + (v[j].z * v[j].z + v[j].w * v[j].w); }
            s = wave_sum(s);
            u32x2* o8 = (u32x2*)(XB + (size_t)row * D) + lane;
#pragma unroll
            for (int j = 0; j < 4; ++j) { u32x2 w; w.x = cvt_pk_bf16(v[j].x, v[j].y); w.y = cvt_pk_bf16(v[j].z, v[j].w); o8[64 * j] = w; }
            if (lane < 16) SS[(size_t)row * 16 + lane] = lane == 0 ? s : 0.f;
        }
    PH_END(0)
    SEAM(0);
    PH_BEGIN(1)
        pg8::Gemm g{XB, W1, M, 4 * D, D}; pg8::StaticOrder S; S.init(M, 4 * D, G, (int)blockIdx.x);
        pg8::EpiInProj E{SS, LB, Qb, LOGF};
        pg8::gemm_phase<pg8::EpiInProj, pg8::StaticOrder, true, true>(lds, g, S, E);
    PH_END(1)
    SEAM(1);
    PH_BEGIN(2)
        for (int it = (int)blockIdx.x; it < 1024; it += G) { const int b = it >> 7, h = (it >> 4) & 7, p = it & 15;
            recur_item<false>(lds, tid, wave, lane, nullptr, LOGF, Vb, nullptr, b * TP + p * 256, 256, 4, h, nullptr, LOCAL + (size_t)it * 16384, DEC + (size_t)it * 128, nullptr, pt0, pacc); }
    PH_END(2)
    SEAM(2);
    PH_BEGIN(3)
        for (int e4 = (int)blockIdx.x * 512 + tid; e4 < 64 * 4096; e4 += G * 512) { const int bh = e4 >> 12, e = (e4 & 4095) * 4;
            f32x4 c = (f32x4){0.f, 0.f, 0.f, 0.f};
#pragma unroll 4
            for (int p = 0; p < 16; ++p) { f32x4* lp = (f32x4*)(LOCAL + ((size_t)(bh * 16 + p)) * 16384 + e); const f32x4 L = *lp; const float d = DEC[(size_t)(bh * 16 + p) * 128 + (e >> 7)];
                *lp = c; c = c * d + L; }
            *(f32x4*)(out + O_SHP + (size_t)bh * 16384 + e) = c; }
    PH_END(3)
    SEAM(3);
    PH_BEGIN(4)
        for (int it = (int)blockIdx.x; it < 1024 + 128; it += G) {
            if (it < 1024) { const int b = it >> 7, h = (it >> 4) & 7, p = it & 15;
                recur_item<true>(lds, tid, wave, lane, Qb, LOGF, Vb, SGb, b * TP + p * 256, 256, 4, h, LOCAL + (size_t)it * 16384, nullptr, nullptr, XA, pt0, pacc); }
            else { const int j = (it - 1024) >> 3, h = (it - 1024) & 7;
                recur_item<true>(lds, tid, wave, lane, Qb, LOGF, Vb, SGb, MP + j * TS, TS, 1, h, state_hgrn + (size_t)(j * 8 + h) * 16384, out + O_SHS + (size_t)(j * 8 + h) * 16384, nullptr, XA, pt0, pacc); }
        }
    PH_END(4)
    SEAM(4);
    PH_BEGIN(5)
        pg8::Gemm g{XA, W2, M, D, D}; pg8::StaticOrder S; S.init(M, D, G, (int)blockIdx.x);
        typedef pg8::EpiRes<false, true, false> Epi5; Epi5 E{x_prompt, x_sample, nullptr, nullptr, XB, SS};
        pg8::gemm_phase<Epi5, pg8::StaticOrder, true, true>(lds, g, S, E);
    PH_END(5)
    SEAM(5);
    PH_BEGIN(6)
        pg8::Gemm g{XB, W3, M, FF, D}; pg8::StaticOrder S; S.init(M, FF, G, (int)blockIdx.x);
        pg8::EpiUp E{SS, HID};
        pg8::gemm_phase<pg8::EpiUp, pg8::StaticOrder, true, true>(lds, g, S, E);
    PH_END(6)
    SEAM(6);
    PH_BEGIN(7)
        pg8::Gemm g{HID, W4, M, D, FF}; pg8::StaticOrder S; S.init(M, D, G, (int)blockIdx.x);
        typedef pg8::EpiRes<true, true, false> Epi7; Epi7 E{nullptr, nullptr, XB, nullptr, XA, SS};
        pg8::gemm_phase<Epi7, pg8::StaticOrder, true, true>(lds, g, S, E);
    PH_END(7)
    SEAM(7);
    PH_BEGIN(8)
        pg8::Gemm g{XA, W5, M, 3 * D, D}; pg8::StaticOrder S; S.init(M, 3 * D, G, (int)blockIdx.x);
        pg8::EpiConvIn E{SS, BG, Zb, out + O_SCP, out + O_SCS};
        pg8::gemm_phase<pg8::EpiConvIn, pg8::StaticOrder, true, true>(lds, g, S, E);
    PH_END(8)
    SEAM(8);
    PH_BEGIN(9)
        for (int row = gw; row < M; row += NGW) {
            int t, sq; if (row < MP) { t = row & (TP - 1); sq = -1; } else { t = (row - MP) & (TS - 1); sq = (row - MP) >> 5; }
#pragma unroll
            for (int j = 0; j < 2; ++j) { const int c0 = 8 * lane + 512 * j;
                const u32x4 bgw = *(const u32x4*)(BG + (size_t)row * D + c0), z0w = *(const u32x4*)(Zb + (size_t)row * D + c0);
                float z1[8], z2[8];
                if (t >= 1) { const u32x4 w = *(const u32x4*)(Zb + (size_t)(row - 1) * D + c0); z1[0] = bf_lo(w.x); z1[1] = bf_hi(w.x); z1[2] = bf_lo(w.y); z1[3] = bf_hi(w.y); z1[4] = bf_lo(w.z); z1[5] = bf_hi(w.z); z1[6] = bf_lo(w.w); z1[7] = bf_hi(w.w); }
                else if (sq >= 0) { const f32x4 a = *(const f32x4*)(state_conv + ((size_t)sq * 2 + 1) * D + c0), b = *(const f32x4*)(state_conv + ((size_t)sq * 2 + 1) * D + c0 + 4); z1[0] = a.x; z1[1] = a.y; z1[2] = a.z; z1[3] = a.w; z1[4] = b.x; z1[5] = b.y; z1[6] = b.z; z1[7] = b.w; }
                else {
#pragma unroll
                    for (int k = 0; k < 8; ++k) z1[k] = 0.f; }
                if (t >= 2) { const u32x4 w = *(const u32x4*)(Zb + (size_t)(row - 2) * D + c0); z2[0] = bf_lo(w.x); z2[1] = bf_hi(w.x); z2[2] = bf_lo(w.y); z2[3] = bf_hi(w.y); z2[4] = bf_lo(w.z); z2[5] = bf_hi(w.z); z2[6] = bf_lo(w.w); z2[7] = bf_hi(w.w); }
                else if (sq >= 0) { const f32x4 a = *(const f32x4*)(state_conv + ((size_t)sq * 2 + t) * D + c0), b = *(const f32x4*)(state_conv + ((size_t)sq * 2 + t) * D + c0 + 4); z2[0] = a.x; z2[1] = a.y; z2[2] = a.z; z2[3] = a.w; z2[4] = b.x; z2[5] = b.y; z2[6] = b.z; z2[7] = b.w; }
                else {
#pragma unroll
                    for (int k = 0; k < 8; ++k) z2[k] = 0.f; }
                const float z0[8] = {bf_lo(z0w.x), bf_hi(z0w.x), bf_lo(z0w.y), bf_hi(z0w.y), bf_lo(z0w.z), bf_hi(z0w.z), bf_lo(z0w.w), bf_hi(z0w.w)};
                const float bg[8] = {bf_lo(bgw.x), bf_hi(bgw.x), bf_lo(bgw.y), bf_hi(bgw.y), bf_lo(bgw.z), bf_hi(bgw.z), bf_lo(bgw.w), bf_hi(bgw.w)};
                const f32x4 wa0 = *(const f32x4*)(conv_w + c0), wa1 = *(const f32x4*)(conv_w + c0 + 4), wb0 = *(const f32x4*)(conv_w + D + c0), wb1 = *(const f32x4*)(conv_w + D + c0 + 4), wc0 = *(const f32x4*)(conv_w + 2 * D + c0), wc1 = *(const f32x4*)(conv_w + 2 * D + c0 + 4);
                const float w0[8] = {wa0.x, wa0.y, wa0.z, wa0.w, wa1.x, wa1.y, wa1.z, wa1.w}, w1[8] = {wb0.x, wb0.y, wb0.z, wb0.w, wb1.x, wb1.y, wb1.z, wb1.w}, w2[8] = {wc0.x, wc0.y, wc0.z, wc0.w, wc1.x, wc1.y, wc1.z, wc1.w};
                float y[8];
#pragma unroll
                for (int k = 0; k < 8; ++k) y[k] = bg[k] * (z2[k] * w0[k] + z1[k] * w1[k] + z0[k] * w2[k]);
                u32x4 o; o.x = cvt_pk_bf16(y[0], y[1]); o.y = cvt_pk_bf16(y[2], y[3]); o.z = cvt_pk_bf16(y[4], y[5]); o.w = cvt_pk_bf16(y[6], y[7]);
                *(u32x4*)(XB + (size_t)row * D + c0) = o; }
        }
    PH_END(9)
    SEAM(9);
    PH_BEGIN(10)
        pg8::Gemm g{XB, W6, M, D, D}; pg8::StaticOrder S; S.init(M, D, G, (int)blockIdx.x);
        typedef pg8::EpiRes<true, true, false> Epi10; Epi10 E{nullptr, nullptr, XA, nullptr, XA, SS};
        pg8::gemm_phase<Epi10, pg8::StaticOrder, true, true>(lds, g, S, E);
    PH_END(10)
    SEAM(10);
    PH_BEGIN(11)
        pg8::Gemm g{XA, W7, M, FF, D}; pg8::StaticOrder S; S.init(M, FF, G, (int)blockIdx.x);
        pg8::EpiUp E{SS, HID};
        pg8::gemm_phase<pg8::EpiUp, pg8::StaticOrder, true, true>(lds, g, S, E);
    PH_END(11)
    SEAM(11);
    PH_BEGIN(12)
        pg8::Gemm g{HID, W8, M, D, FF}; pg8::StaticOrder S; S.init(M, D, G, (int)blockIdx.x);
        typedef pg8::EpiRes<true, false, true> Epi12; Epi12 E{nullptr, nullptr, XA, H, nullptr, SS};
        pg8::gemm_phase<Epi12, pg8::StaticOrder, true, true>(lds, g, S, E);
    PH_END(12)
    SEAM(12);
    PH_BEGIN(13)
        for (int row = gw; row < M; row += NGW) {
            const float r = pg8::row_rstd(SS, row);
            f32x4* hp = (f32x4*)(H + (size_t)row * D) + lane; const f32x4* gp = (const f32x4*)norm_final + lane;
#pragma unroll
            for (int j = 0; j < 4; ++j) { const f32x4 v = hp[64 * j], gg = gp[64 * j]; hp[64 * j] = v * r * gg; }
        }
    PH_END(13)
#ifdef PROBE_ID
    if (blockIdx.x == 0 && tid == 0) { const unsigned long long te = __builtin_amdgcn_s_memtime(); while (__builtin_amdgcn_s_memtime() - te < (unsigned long long)PROBE_MULT * pacc) __builtin_amdgcn_s_sleep(8); }
#endif
#undef IN
#undef SEAM
#undef ctl
#undef x_prompt
#undef x_sample
#undef state_hgrn
#undef state_conv
#undef norm_mix
#undef norm_mlp
#undef norm_final
#undef w_in_hgrn
#undef lb_hgrn
#undef g_norm_hgrn
#undef w_out_hgrn
#undef w_in_conv
#undef conv_w
#undef w_out_conv
#undef w_up
#undef w_down
#undef out
#undef H
#undef LB
#undef SS
#undef DEC
#undef W1
#undef W2
#undef W3
#undef W4
#undef W5
#undef W6
#undef W7
#undef W8
#undef XA
#undef XB
#undef LOCAL
#undef Qb
#undef Vb
#undef SGb
#undef LOGF
#undef HID
#undef BG
#undef Zb
}


extern "C" void kernel_launch(void* const* d_in, const int* in_sizes, int n_in, void* d_out, int out_size, void* d_ws, size_t ws_size, hipStream_t stream) {
    static int grid = 0;
    if (grid == 0) {
        if (n_in != 16 || in_sizes[0] != MP * D || in_sizes[1] != MS * D || (size_t)out_size != O_END || ws_size < WS_END) {
            fprintf(stderr, "kernel_launch: unexpected shapes: n_in %d in0 %d in1 %d out %d ws %zu (need >= %zu); nothing launched\n", n_in, n_in > 0 ? in_sizes[0] : -1, n_in > 1 ? in_sizes[1] : -1, out_size, ws_size, (size_t)WS_END); grid = -1; return; }
        int dev = 0, cus = 0, per_cu = 0;
        if (hipGetDevice(&dev) != hipSuccess || hipDeviceGetAttribute(&cus, hipDeviceAttributeMultiprocessorCount, dev) != hipSuccess) { fprintf(stderr, "kernel_launch: device query failed\n"); grid = -1; return; }
        if (hipFuncSetAttribute((const void*)mk_fwd, hipFuncAttributeMaxDynamicSharedMemorySize, LDS_BYTES) != hipSuccess) { fprintf(stderr, "kernel_launch: hipFuncSetAttribute failed\n"); grid = -1; return; }
        if (hipOccupancyMaxActiveBlocksPerMultiprocessor(&per_cu, (const void*)mk_fwd, 512, LDS_BYTES) != hipSuccess || per_cu < 1) { fprintf(stderr, "kernel_launch: occupancy query says %d blocks per CU\n", per_cu); (void)hipGetLastError(); grid = -1; return; }
        grid = cus;
        fprintf(stderr, "kernel_launch: grid %d (occupancy query %d per CU), ws %zu\n", grid, per_cu, ws_size);
    }
    if (grid < 0) return;
    (void)hipMemsetAsync((char*)d_ws + WS_CTL, 0, CTL_ZERO_BYTES, stream);
    Args a{};
    for (int i = 0; i < 16; ++i) a.in[i] = (const float*)d_in[i];
    a.outp = (float*)d_out; a.wsp = (unsigned char*)d_ws; a.ph_lo = 0;
#if DBG_STAGE >= 1
    a.ph_hi = (DBG_STAGE == 1) ? 2 : DBG_STAGE + 3;
#else
    a.ph_hi = N_PHASES;
#endif
    hipLaunchKernelGGL(mk_fwd, dim3(grid), dim3(512), LDS_BYTES, stream, a);
#if DBG_STAGE >= 1
    nv::forward_from(DBG_STAGE, d_in, (float*)d_out, (unsigned char*)d_ws, stream);
#endif
}
```
